# Optimizing an MI355X kernel written in HIP

```python
import jax, jax.numpy as jnp
from jax import lax
import numpy as np

D_MODEL = 2048
BATCH = 1
SEQ = 16384
DEPTH = 2
DEC_BATCH = 32
DEC_SEQ = 16
PAST_LEN = 2048

CHUNK = 64
N_MIXERS = 2
N_POOL_LAYERS = (DEPTH + 1) // 2
N_FOX_LAYERS = DEPTH // 2
POOL_WINDOWS = (2, 4, 8, 16)
N_POOL_GROUPS = len(POOL_WINDOWS)
POOL_GROUP = D_MODEL // N_POOL_GROUPS
POOL_STATE = max(POOL_WINDOWS) - 1
FOX_HEAD_DIM = 128
FOX_HEADS = D_MODEL // FOX_HEAD_DIM
D_FF = 4 * D_MODEL
Q_BLOCK = 128
LN_EPS = 1e-5
DN_ALPHA = (2 * DEPTH) ** 0.25
DN_BETA = (8 * DEPTH) ** -0.25
FORGET_BIAS_INIT = 3.0

kernel_name = "pool_fox_macaron_deepnorm_stream_step"


def layer_norm(x, g, b):
    xf = x.astype(jnp.float32)
    mu = jnp.mean(xf, axis=-1, keepdims=True)
    var = jnp.mean(jnp.square(xf - mu), axis=-1, keepdims=True)
    return ((xf - mu) * lax.rsqrt(var + LN_EPS) * g + b).astype(x.dtype)


def swiglu(x, w1, w3, w2):
    return (jax.nn.silu(x @ w1) * (x @ w3)) @ w2


def pool_mix(x, prev, start_pos, w_grp, scale):
    B, T, D = x.shape
    xr = jnp.concatenate([prev, x], axis=1)
    xe = xr.astype(jnp.float32)
    cs = jnp.concatenate([jnp.zeros_like(xe[:, :1]), jnp.cumsum(xe, axis=1)], axis=1)
    end = cs[:, POOL_STATE + 1:]
    pos = start_pos + jnp.arange(T)
    diffs = []
    for g, w in enumerate(POOL_WINDOWS):
        sl = slice(g * POOL_GROUP, (g + 1) * POOL_GROUP)
        win = end[:, :, sl] - cs[:, POOL_STATE + 1 - w:POOL_STATE + 1 - w + T, sl]
        cnt = jnp.minimum(pos + 1, w).astype(jnp.float32)[None, :, None]
        diffs.append(win / cnt - xe[:, POOL_STATE:, sl])
    d = jnp.stack(diffs, axis=2).astype(x.dtype)
    y = jnp.einsum('btgc,gcd->btgd', d, w_grp).reshape(B, T, D)
    return y * scale, xr[:, -POOL_STATE:]


def fox_project(x, w_in, b_f):
    B, T, D = x.shape
    p = x @ w_in
    q, k, v, fl = jnp.split(p, [D, 2 * D, 3 * D], axis=-1)
    shp = (B, T, FOX_HEADS, FOX_HEAD_DIM)
    logf = jax.nn.log_sigmoid(fl.astype(jnp.float32) + b_f.astype(jnp.float32))
    return q.reshape(shp), k.reshape(shp), v.reshape(shp), logf


def fox_attend_prompt(q, k, v, logf):
    B, S, H, DH = q.shape
    scale = DH ** -0.5
    c = jnp.cumsum(logf, axis=1)
    cT = c.transpose(0, 2, 1)
    nb = S // Q_BLOCK
    qb = q.reshape(B, nb, Q_BLOCK, H, DH).transpose(1, 0, 2, 3, 4)
    cb = cT.reshape(B, H, nb, Q_BLOCK).transpose(2, 0, 1, 3)
    kpos = jnp.arange(S)

    def block(args):
        i, qi, ci = args
        s = jnp.einsum('bqhd,bkhd->bhqk', qi, k, preferred_element_type=jnp.float32) * scale
        s = s + ci[..., None] - cT[:, :, None, :]
        qpos = i * Q_BLOCK + jnp.arange(Q_BLOCK)
        s = jnp.where(kpos[None, :] <= qpos[:, None], s, -jnp.inf)
        p = jax.nn.softmax(s, axis=-1)
        return jnp.einsum('bhqk,bkhd->bqhd', p.astype(v.dtype), v)

    o = lax.map(block, (jnp.arange(nb), qb, cb))
    return o.transpose(1, 0, 2, 3, 4).reshape(B, S, H * DH)


def fox_attend_sample(q, k_new, v_new, logf_new, k_cache, v_cache, logf_cache):
    B, T, H, DH = q.shape
    P = k_cache.shape[1]
    scale = DH ** -0.5
    k = jnp.concatenate([k_cache.astype(k_new.dtype), k_new], axis=1)
    v = jnp.concatenate([v_cache.astype(v_new.dtype), v_new], axis=1)
    lf = jnp.concatenate([logf_cache.astype(jnp.float32), logf_new], axis=1)
    cT = jnp.cumsum(lf, axis=1).transpose(0, 2, 1)
    s = jnp.einsum('bqhd,bkhd->bhqk', q, k, preferred_element_type=jnp.float32) * scale
    s = s + cT[:, :, P:, None] - cT[:, :, None, :]
    qpos = P + jnp.arange(T)
    kpos = jnp.arange(P + T)
    s = jnp.where(kpos[None, :] <= qpos[:, None], s, -jnp.inf)
    p = jax.nn.softmax(s, axis=-1)
    o = jnp.einsum('bhqk,bkhd->bqhd', p.astype(v.dtype), v)
    return o.reshape(B, T, H * DH)


def run_trunk(x, start_pos, pool_prev, fox_cache, ln_g, ln_b, ffn_w1, ffn_w3, ffn_w2,
              pool_w, pool_scale, fox_w_in, fox_b_f, fox_w_o):
    B = x.shape[0]
    pool_new, k_new, v_new, lf_new = [], [], [], []
    for i in range(DEPTH):
        j = i // N_MIXERS
        h = swiglu(x, ffn_w1[i, 0], ffn_w3[i, 0], ffn_w2[i, 0])
        x = layer_norm(DN_ALPHA * x + 0.5 * h, ln_g[i, 0], ln_b[i, 0])
        if i % N_MIXERS == 0:
            prev = jnp.zeros((B, POOL_STATE, D_MODEL), x.dtype) if pool_prev is None else pool_prev[j].astype(x.dtype)
            m, st = pool_mix(x, prev, start_pos, pool_w[j], pool_scale[j])
            pool_new.append(st)
        else:
            q, k, v, lf = fox_project(x, fox_w_in[j], fox_b_f[j])
            if fox_cache is None:
                o = fox_attend_prompt(q, k, v, lf)
            else:
                ck, cv, cl = fox_cache
                o = fox_attend_sample(q, k, v, lf, ck[j], cv[j], cl[j])
            m = o @ fox_w_o[j]
            k_new.append(k)
            v_new.append(v)
            lf_new.append(lf)
        x = layer_norm(DN_ALPHA * x + m, ln_g[i, 1], ln_b[i, 1])
        h = swiglu(x, ffn_w1[i, 1], ffn_w3[i, 1], ffn_w2[i, 1])
        x = layer_norm(DN_ALPHA * x + 0.5 * h, ln_g[i, 2], ln_b[i, 2])
    return x, jnp.stack(pool_new), jnp.stack(k_new), jnp.stack(v_new), jnp.stack(lf_new)


def setup_inputs(seed: int = 0) -> dict:
    key = jax.random.key(seed)
    ks = jax.random.split(key, 20)
    f32 = jnp.float32

    def nrm(k, shape, s):
        return jax.random.normal(k, shape, f32) * s

    D, H = D_MODEL, FOX_HEADS
    x_prompt = nrm(ks[0], (BATCH, SEQ, D), 1.0)
    x_sample = nrm(ks[1], (DEC_BATCH, DEC_SEQ, D), 1.0)
    state_pool = nrm(ks[2], (N_POOL_LAYERS, DEC_BATCH, POOL_STATE, D), 1.0)
    cache_fox_k = nrm(ks[3], (N_FOX_LAYERS, DEC_BATCH, PAST_LEN, H, FOX_HEAD_DIM), 1.0)
    cache_fox_v = nrm(ks[4], (N_FOX_LAYERS, DEC_BATCH, PAST_LEN, H, FOX_HEAD_DIM), 1.0)
    cache_fox_logf = jax.nn.log_sigmoid(FORGET_BIAS_INIT + nrm(ks[5], (N_FOX_LAYERS, DEC_BATCH, PAST_LEN, H), 1.0))
    ln_g = 1.0 + nrm(ks[6], (DEPTH, 3, D), 0.02)
    ln_b = nrm(ks[7], (DEPTH, 3, D), 0.02)
    ffn_w1 = nrm(ks[8], (DEPTH, 2, D, D_FF), D ** -0.5)
    ffn_w3 = nrm(ks[9], (DEPTH, 2, D, D_FF), D ** -0.5)
    ffn_w2 = nrm(ks[10], (DEPTH, 2, D_FF, D), D_FF ** -0.5 * DN_BETA)
    pool_w = nrm(ks[11], (N_POOL_LAYERS, N_POOL_GROUPS, POOL_GROUP, POOL_GROUP), POOL_GROUP ** -0.5 * DN_BETA)
    pool_scale = 1.0 + nrm(ks[12], (N_POOL_LAYERS, D), 0.02)
    w_qk = nrm(ks[13], (N_FOX_LAYERS, D, 2 * D), D ** -0.5)
    w_v = nrm(ks[14], (N_FOX_LAYERS, D, D), D ** -0.5 * DN_BETA)
    w_f = nrm(ks[15], (N_FOX_LAYERS, D, H), D ** -0.5)
    fox_w_in = jnp.concatenate([w_qk, w_v, w_f], axis=-1)
    fox_b_f = FORGET_BIAS_INIT + nrm(ks[16], (N_FOX_LAYERS, H), 0.1)
    fox_w_o = nrm(ks[17], (N_FOX_LAYERS, D, D), D ** -0.5 * DN_BETA)
    return {"x_prompt": x_prompt, "x_sample": x_sample, "state_pool": state_pool,
            "cache_fox_k": cache_fox_k, "cache_fox_v": cache_fox_v, "cache_fox_logf": cache_fox_logf,
            "ln_g": ln_g, "ln_b": ln_b, "ffn_w1": ffn_w1, "ffn_w3": ffn_w3, "ffn_w2": ffn_w2,
            "pool_w": pool_w, "pool_scale": pool_scale, "fox_w_in": fox_w_in, "fox_b_f": fox_b_f,
            "fox_w_o": fox_w_o}


def reference(x_prompt, x_sample, state_pool, cache_fox_k, cache_fox_v, cache_fox_logf,
              ln_g, ln_b, ffn_w1, ffn_w3, ffn_w2, pool_w, pool_scale, fox_w_in, fox_b_f, fox_w_o):
    y_prompt, pool_p, k_p, v_p, lf_p = run_trunk(
        x_prompt, 0, None, None, ln_g, ln_b, ffn_w1, ffn_w3, ffn_w2,
        pool_w, pool_scale, fox_w_in, fox_b_f, fox_w_o)
    past = cache_fox_k.shape[2]
    y_sample, pool_s, k_s, v_s, lf_s = run_trunk(
        x_sample, past, state_pool, (cache_fox_k, cache_fox_v, cache_fox_logf),
        ln_g, ln_b, ffn_w1, ffn_w3, ffn_w2, pool_w, pool_scale, fox_w_in, fox_b_f, fox_w_o)
    return (y_prompt, y_sample, pool_p, pool_s, k_p, v_p, lf_p, k_s, v_s, lf_s)
```

```cpp
#include <hip/hip_runtime.h>
#include <cstdio>
#include <cstdint>

#ifndef MK_SPLIT
#define MK_SPLIT 0
#endif

#define LAS __attribute__((address_space(3)))
#define GAS __attribute__((address_space(1)))
typedef unsigned short bf16;
typedef short bf16x8 __attribute__((ext_vector_type(8)));
typedef float f32x4 __attribute__((ext_vector_type(4)));
typedef float f32x2 __attribute__((ext_vector_type(2)));
typedef float f32x16 __attribute__((ext_vector_type(16)));
typedef unsigned u32x4 __attribute__((ext_vector_type(4)));
typedef unsigned u32x2 __attribute__((ext_vector_type(2)));
typedef unsigned v4u __attribute__((ext_vector_type(4)));
typedef __bf16 bf16x2_t __attribute__((ext_vector_type(2)));

constexpr int D = 2048, SEQ = 16384, NS = 512, M = SEQ + NS, FF = 8192, NH = 16, DH = 128, PAST = 2048, DECB = 32, DECT = 16, PST = 15;
constexpr int WIN_LD = 3 * D + NH;
constexpr float ALPHA = 1.41421356237309515f, LN_EPS = 1e-5f;
constexpr float LOG2E = 1.4426950408889634f;
constexpr float QSCALE = 0.08838834764831845f * 1.4426950408889634f;

constexpr size_t O_YP = 0, O_YS = 33554432, O_PP = 34603008, O_PS = 34633728, O_KP = 35616768, O_VP = 69171200, O_LP = 102725632, O_KS = 102987776, O_VS = 104036352, O_LS = 105084928, O_END = 105093120;

constexpr size_t MiB = 1u << 20;
constexpr size_t WS_CTL = 0, CTL_ZERO_BYTES = 1 * MiB;
constexpr size_t WS_W13 = 2 * MiB;
constexpr size_t WS_W2T = 258 * MiB;
constexpr size_t WS_WIN = 386 * MiB;
constexpr size_t WS_WO = 410 * MiB;
constexpr size_t WS_POOLT = 418 * MiB;
constexpr size_t WS_S = 420 * MiB;
constexpr size_t WS_XBF = 552 * MiB;
constexpr size_t WS_HB = 618 * MiB;
constexpr size_t WS_DB = 882 * MiB;
constexpr size_t WS_QB = 948 * MiB, WS_KB = 1014 * MiB, WS_VB = 1080 * MiB;
constexpr size_t WS_VT = 1146 * MiB;
constexpr size_t WS_OB = 1210 * MiB;
constexpr size_t WS_CL = 1276 * MiB;
constexpr size_t WS_END = 1278 * MiB;
constexpr int CW_TMO = 0, CW_BAR = 4096;

namespace pg8 {
constexpr int BM = 256, BK = 64, HALF = 128, HTB = HALF * BK * 2, STAGE_BYTES = 8 * HTB, NXCD = 8, WGM = 8;
__host__ __device__ __forceinline__ int lds_byte(int r, int c) { const int st = (r >> 4) * 2 + (c >> 5), rr = r & 15, cc = c & 31, ob = rr * 64 + cc * 2; return st * 1024 + (ob ^ (((ob >> 9) & 1) << 5)); }
__host__ __device__ __forceinline__ void stage_rc(int b, int& R, int& C) { const int st = b / 1024, sb = b % 1024, swz = sb ^ (((sb >> 9) & 1) << 5); R = (st >> 1) * 16 + swz / 64; C = (st & 1) * 32 + (swz % 64) / 2; }
__host__ __device__ __forceinline__ int perm32(int rho) { const int n = rho >> 4, i = rho & 15; return 8 * (i >> 2) + 4 * n + (i & 3); }

struct Unit { int pm, pn; };
struct Gemm { const bf16* A; const bf16* Bt; int lda, ldb, K; };

struct StaticOrder {
    int nM, nN, nwg, G, c, gdiv; unsigned gkb;
    __device__ void init(int M_, int N_, int G_, int c_, int gdiv_ = 0, unsigned gkb_ = 0) { nM = M_ / BM; nN = N_ / BM; nwg = nM * nN; G = G_; c = c_; gdiv = gdiv_; gkb = gkb_; }
    __device__ bool next(int i, Unit& u) const {
        const long L = (long)i * G + c; if (L >= nwg) return false;
        int wgid = (int)L; { const int q = nwg / NXCD, r = nwg % NXCD, xcd = wgid % NXCD, off = wgid / NXCD; wgid = (xcd < r ? xcd * (q + 1) : r * (q + 1) + (xcd - r) * q) + off; }
        const int nig = WGM * nN, gid = wgid / nig, fm = gid * WGM, gsz = (nM - fm) < WGM ? (nM - fm) : WGM;
        u.pm = fm + ((wgid % nig) % gsz); u.pn = (wgid % nig) / gsz; return true;
    }
    __device__ __forceinline__ size_t a_off(const Unit& u) const { return gdiv ? (size_t)(u.pn / gdiv) * gkb : (size_t)0; }
};

__device__ __forceinline__ unsigned cvt_pk_bf16(float lo, float hi) { unsigned r; asm volatile("v_cvt_pk_bf16_f32 %0, %1, %2" : "=v"(r) : "v"(lo), "v"(hi)); return r; }


struct EpiSwiglu {
    static constexpr bool PERM = true;
    bf16* Hout;
    __device__ __forceinline__ void operator()(const f32x4 (&acc)[2][2][4][2], const Unit& u, int wr, int wc, int fr, int fq) const {
        const int row0 = u.pm * BM + wr * 64 + fr, col0 = u.pn * HALF + wc * 32 + 8 * fq;
#pragma unroll
        for (int ai = 0; ai < 2; ++ai)
#pragma unroll
            for (int m = 0; m < 4; ++m) {
                bf16* rowp = Hout + (size_t)(row0 + ai * HALF + m * 16) * FF + col0;
                float hv[8];
#pragma unroll
                for (int n = 0; n < 2; ++n)
#pragma unroll
                    for (int j = 0; j < 4; ++j) { const float a = acc[ai][0][m][n][j], b = acc[ai][1][m][n][j];
                        const float sg = __builtin_amdgcn_rcpf(1.0f + __builtin_amdgcn_exp2f(-a * LOG2E)); hv[n * 4 + j] = a * sg * b; }
                u32x4 w; w.x = cvt_pk_bf16(hv[0], hv[1]); w.y = cvt_pk_bf16(hv[2], hv[3]); w.z = cvt_pk_bf16(hv[4], hv[5]); w.w = cvt_pk_bf16(hv[6], hv[7]);
                *(u32x4*)rowp = w; }
    }
};
struct EpiResid {
    static constexpr bool PERM = false;
    float* S; const float* srcP; const float* srcS; float r; const float* cs;
    __device__ __forceinline__ void operator()(const f32x4 (&acc)[2][2][4][2], const Unit& u, int wr, int wc, int fr, int fq) const {
        const int col0 = u.pn * BM + wc * 32 + 4 * fq; const int rowb = u.pm * BM + wr * 64 + fr;
        const float* src = (rowb < SEQ) ? srcP : (srcS - (size_t)SEQ * D);
        f32x4 sc[2][2];
#pragma unroll
        for (int bj = 0; bj < 2; ++bj)
#pragma unroll
            for (int n = 0; n < 2; ++n) { sc[bj][n] = cs ? *(const f32x4*)(cs + col0 + bj * HALF + n * 16) : (f32x4){1.f, 1.f, 1.f, 1.f}; sc[bj][n] = sc[bj][n] * r; }
#pragma unroll
        for (int ai = 0; ai < 2; ++ai)
#pragma unroll
            for (int m = 0; m < 4; ++m) { const size_t off = (size_t)(rowb + ai * HALF + m * 16) * D + col0;
#pragma unroll
                for (int bj = 0; bj < 2; ++bj)
#pragma unroll
                    for (int n = 0; n < 2; ++n) { const f32x4 x = *(const f32x4*)(src + off + bj * HALF + n * 16);
                        *(f32x4*)(S + off + bj * HALF + n * 16) = x * ALPHA + acc[ai][bj][m][n] * sc[bj][n]; }
                asm volatile("" ::: "memory"); }
    }
};
struct EpiQKV {
    static constexpr bool PERM = true;
    bf16* Q; size_t bstride; float *kP, *kS;
    __device__ __forceinline__ void operator()(const f32x4 (&acc)[2][2][4][2], const Unit& u, int wr, int wc, int fr, int fq) const {
        const int t = u.pn >> 3, colt = (u.pn & 7) * BM; const int rowb = u.pm * BM + wr * 64 + fr, col0 = colt + wc * 32 + 8 * fq;
        bf16* ob = Q + (size_t)t * bstride;
        const size_t tv = (t == 2) ? 1 : 0;
        float* of = (rowb < SEQ) ? (kP + tv * (O_VP - O_KP)) : (kS + tv * (O_VS - O_KS) - (size_t)SEQ * D);
        const float sc = (t == 0) ? QSCALE : 1.0f;
#pragma unroll
        for (int ai = 0; ai < 2; ++ai)
#pragma unroll
            for (int m = 0; m < 4; ++m) { const size_t off = (size_t)(rowb + ai * HALF + m * 16) * D + col0;
#pragma unroll
                for (int bj = 0; bj < 2; ++bj) { const f32x4 v0 = acc[ai][bj][m][0], v1 = acc[ai][bj][m][1];
                    u32x4 w; w.x = cvt_pk_bf16(v0[0] * sc, v0[1] * sc); w.y = cvt_pk_bf16(v0[2] * sc, v0[3] * sc); w.z = cvt_pk_bf16(v1[0] * sc, v1[1] * sc); w.w = cvt_pk_bf16(v1[2] * sc, v1[3] * sc);
                    *(u32x4*)(ob + off + bj * HALF) = w;
                    if (t != 0) { *(f32x4*)(of + off + bj * HALF) = v0; *(f32x4*)(of + off + bj * HALF + 4) = v1; } } }
    }
};

template <class Epi, class Sched, bool ALIGN_EPI = true>
__device__ __forceinline__ void gemm_phase(LAS unsigned char* lds, const Gemm g, const Sched& S, const Epi& E) {
    const int tid = threadIdx.x, wid = __builtin_amdgcn_readfirstlane(tid >> 6), lane = tid & 63, wr = wid >> 2, wc = wid & 3, fr = lane & 15, fq = lane >> 4;
    const int K = g.K, nt = K / BK;
    unsigned voffA[2], voffB[2];
#pragma unroll
    for (int i = 0; i < 2; ++i) { int R, C; stage_rc(tid * 16 + i * 8192, R, C); const int Rb = Epi::PERM ? ((R & ~31) + perm32(R & 31)) : R;
        voffA[i] = (unsigned)(R * g.lda + C) * 2u; voffB[i] = (unsigned)(Rb * g.ldb + C) * 2u; }
    const size_t kstep = (size_t)(BK * 2);
    const size_t hstepA = (size_t)HALF * g.lda * 2, hstepB = (size_t)HALF * g.ldb * 2;
    const size_t tstepA = 2 * hstepA, tstepB = 2 * hstepB;
    const unsigned ldsw = (unsigned)wid * 1024u;
    const int aoff = lds_byte(wr * 64 + fr, fq * 8), boff = lds_byte(wc * 32 + fr, fq * 8);
#define PG8_SA(b, h) (((b) * 2 + (h)) * HTB)
#define PG8_SB(b, h) ((4 + (b) * 2 + (h)) * HTB)
#define PG8_STAGE(bufoff, gbase, voff) do { _Pragma("unroll") for (int _i = 0; _i < 2; ++_i) \
        __builtin_amdgcn_global_load_lds((const unsigned*)((const char*)(gbase) + (voff)[_i]), (LAS unsigned*)(lds + (bufoff) + ldsw + _i * 8192), 16, 0, 0); } while (0)
#define PG8_LDA(dst, b, h) do { _Pragma("unroll") for (int m = 0; m < 4; ++m) _Pragma("unroll") for (int k = 0; k < 2; ++k) dst[m][k] = *(const LAS bf16x8*)(lds + PG8_SA(b, h) + aoff + m * 2048 + k * 1024); } while (0)
#define PG8_LDB(dst, b, h) do { _Pragma("unroll") for (int n = 0; n < 2; ++n) _Pragma("unroll") for (int k = 0; k < 2; ++k) dst[n][k] = *(const LAS bf16x8*)(lds + PG8_SB(b, h) + boff + n * 2048 + k * 1024); } while (0)
#define PG8_MMA(ai, bj, At, Bt) do { __builtin_amdgcn_s_setprio(1); _Pragma("unroll") for (int m = 0; m < 4; ++m) _Pragma("unroll") for (int n = 0; n < 2; ++n) _Pragma("unroll") for (int k = 0; k < 2; ++k) \
        acc[ai][bj][m][n] = __builtin_amdgcn_mfma_f32_16x16x32_bf16(Bt[n][k], At[m][k], acc[ai][bj][m][n], 0, 0, 0); __builtin_amdgcn_s_setprio(0); } while (0)
#define PG8_WAIT_V(n) asm volatile("s_waitcnt vmcnt(" #n ")" ::: "memory")
#define PG8_WAIT_L(n) asm volatile("s_waitcnt lgkmcnt(" #n ")" ::: "memory")
#define PG8_BAR __builtin_amdgcn_s_barrier()
#define PG8_SCHED __builtin_amdgcn_sched_barrier(0)
    Unit cur, nxt; int ui = 0;
    if (!S.next(0, cur)) return;
    f32x4 acc[2][2][4][2];
#pragma unroll
    for (int a = 0; a < 2; ++a)
#pragma unroll
        for (int b = 0; b < 2; ++b)
#pragma unroll
            for (int m = 0; m < 4; ++m)
#pragma unroll
                for (int n = 0; n < 2; ++n) acc[a][b][m][n] = (f32x4){0.f, 0.f, 0.f, 0.f};
    bf16x8 At[4][2], B0[2][2], B1[2][2];
    const char* cA = (const char*)g.A + (size_t)cur.pm * tstepA + S.a_off(cur); const char* cB = (const char*)g.Bt + (size_t)cur.pn * tstepB;
    PG8_STAGE(PG8_SB(0, 0), cB, voffB); PG8_STAGE(PG8_SB(0, 1), cB + hstepB, voffB); PG8_STAGE(PG8_SA(0, 0), cA, voffA); PG8_STAGE(PG8_SA(0, 1), cA + hstepA, voffA);
    if (wr == 1) PG8_BAR;
    PG8_WAIT_V(2); PG8_BAR;
    PG8_STAGE(PG8_SB(1, 0), cB + kstep, voffB); PG8_STAGE(PG8_SA(1, 0), cA + kstep, voffA); PG8_STAGE(PG8_SB(1, 1), cB + hstepB + kstep, voffB);
    PG8_WAIT_V(6); PG8_BAR;
    for (;;) {
        const bool has_next = S.next(ui + 1, nxt);
        const char* nA = has_next ? (const char*)g.A + (size_t)nxt.pm * tstepA + S.a_off(nxt) : cA; const char* nB = has_next ? (const char*)g.Bt + (size_t)nxt.pn * tstepB : cB;
        for (int t = 0; t < nt; t += 2) {
            const bool last = (t == nt - 2);
            const char* a1 = cA + (size_t)(t + 1) * kstep;
            const char* a2 = last ? nA : cA + (size_t)(t + 2) * kstep; const char* b2 = last ? nB : cB + (size_t)(t + 2) * kstep;
            const char* a3 = a2 + kstep; const char* b3 = b2 + kstep;
            PG8_LDB(B0, 0, 0); PG8_LDB(B1, 0, 1); PG8_SCHED; PG8_LDA(At, 0, 0); PG8_STAGE(PG8_SA(1, 1), a1 + hstepA, voffA);
            PG8_WAIT_V(8); PG8_WAIT_L(0); PG8_BAR; PG8_MMA(0, 0, At, B0); PG8_MMA(0, 1, At, B1); PG8_BAR; PG8_SCHED;
            PG8_LDA(At, 0, 1); PG8_STAGE(PG8_SB(0, 0), b2, voffB); PG8_STAGE(PG8_SB(0, 1), b2 + hstepB, voffB); PG8_STAGE(PG8_SA(0, 0), a2, voffA);
            PG8_WAIT_V(8); PG8_WAIT_L(0); PG8_BAR; PG8_MMA(1, 0, At, B0); PG8_MMA(1, 1, At, B1); PG8_BAR; PG8_SCHED;
            PG8_LDB(B0, 1, 0); PG8_LDB(B1, 1, 1); PG8_SCHED; PG8_LDA(At, 1, 0); PG8_STAGE(PG8_SA(0, 1), a2 + hstepA, voffA);
            PG8_WAIT_V(8); PG8_WAIT_L(0); PG8_BAR; PG8_MMA(0, 0, At, B0); PG8_MMA(0, 1, At, B1); PG8_BAR; PG8_SCHED;
            PG8_LDA(At, 1, 1); PG8_STAGE(PG8_SB(1, 0), b3, voffB); PG8_STAGE(PG8_SB(1, 1), b3 + hstepB, voffB); PG8_STAGE(PG8_SA(1, 0), a3, voffA);
            PG8_WAIT_V(8); PG8_WAIT_L(0); PG8_BAR; PG8_MMA(1, 0, At, B0); PG8_MMA(1, 1, At, B1); PG8_BAR; PG8_SCHED;
        }
        if constexpr (ALIGN_EPI) { if (wr == 0) PG8_BAR; }
        E(acc, cur, wr, wc, fr, fq);
        if (!has_next) break;
#pragma unroll
        for (int a = 0; a < 2; ++a)
#pragma unroll
            for (int b = 0; b < 2; ++b)
#pragma unroll
                for (int m = 0; m < 4; ++m)
#pragma unroll
                    for (int n = 0; n < 2; ++n) acc[a][b][m][n] = (f32x4){0.f, 0.f, 0.f, 0.f};
        cur = nxt; cA = nA; cB = nB; ++ui;
        if constexpr (ALIGN_EPI) { if (wr == 1) PG8_BAR; }
    }
    PG8_WAIT_V(0);
    if constexpr (!ALIGN_EPI) { if (wr == 0) PG8_BAR; }
    PG8_BAR;
#undef PG8_SA
#undef PG8_SB
#undef PG8_STAGE
#undef PG8_LDA
#undef PG8_LDB
#undef PG8_MMA
#undef PG8_WAIT_V
#undef PG8_WAIT_L
#undef PG8_BAR
#undef PG8_SCHED
}
}

constexpr int NWAVES = 8;
constexpr int RING_OFF = 0, RING_BYTES = 131072;
constexpr int LDSCTL_OFF = RING_BYTES, MISC_OFF = LDSCTL_OFF + 320;
constexpr int LDS_BYTES = 147456;

typedef GAS unsigned gu32;
#define RLX_AGENT __ATOMIC_RELAXED, __HIP_MEMORY_SCOPE_AGENT
#define LDS_WAIT() asm volatile("s_waitcnt lgkmcnt(0)" ::: "memory")
#define VM_WAIT() asm volatile("s_waitcnt vmcnt(0)" ::: "memory")
__device__ __forceinline__ unsigned f2bf(float f) { unsigned u = __builtin_bit_cast(unsigned, f); return (u + 0x7fffu + ((u >> 16) & 1u)) >> 16; }
__device__ __forceinline__ unsigned pk2(float lo, float hi) { return f2bf(lo) | (f2bf(hi) << 16); }
__device__ __forceinline__ unsigned cvtpk(float lo, float hi) { f32x2 v = {lo, hi}; bf16x2_t b = __builtin_convertvector(v, bf16x2_t); return __builtin_bit_cast(unsigned, b); }
__device__ __forceinline__ float bf_lo(unsigned w) { return __builtin_bit_cast(float, w << 16); }
__device__ __forceinline__ float bf_hi(unsigned w) { return __builtin_bit_cast(float, w & 0xffff0000u); }

#define XB_TMO      128
#define XB_XCNT(j)  (256  + 64 * (j))
#define XB_XSUB(j)  (1280 + 64 * (j))
#define XB_XGEN(j)  (2304 + 64 * (j))
#define XB_TOP      3328
#define XB_TOPGEN   3392
#define XCD_BAR_WORDS 3456
#define XB_SPIN_CAP (1u << 18)
__device__ __forceinline__ unsigned xb_ld(unsigned* p)              { return __hip_atomic_load(p, __ATOMIC_RELAXED, __HIP_MEMORY_SCOPE_AGENT); }
__device__ __forceinline__ unsigned xb_add(unsigned* p, unsigned v) { return __hip_atomic_fetch_add(p, v, __ATOMIC_RELAXED, __HIP_MEMORY_SCOPE_AGENT); }
__device__ __forceinline__ unsigned xb_xcc_id() { return (unsigned)__builtin_amdgcn_s_getreg((3 << 11) | 20) & 0xFu; }
#define XB_SPIN(cond, bar) do { unsigned _sp = 0; while (cond) { __builtin_amdgcn_s_sleep(1); \
    if ((++_sp & 255u) == 0u) { if (xb_ld(&(bar)[XB_TMO])) break; if (_sp > XB_SPIN_CAP) { atomicAdd(&(bar)[XB_TMO], 1u); break; } } } } while (0)
struct XcdBarrier { unsigned* bar; unsigned x; volatile LAS unsigned* st; };
__device__ __forceinline__ XcdBarrier xcd_barrier_post(unsigned* bar, volatile LAS unsigned* st) {
    XcdBarrier b; b.bar = bar; b.x = xb_xcc_id(); b.st = st;
    if (threadIdx.x == 0) (void)xb_add(&bar[XB_XCNT(b.x)], 1u);
    return b;
}
__device__ __forceinline__ void xcd_barrier_complete(unsigned* bar, unsigned x, unsigned& nloc, unsigned& nx) {
    const unsigned G = gridDim.x * gridDim.y * gridDim.z;
    unsigned sum, cnt, mine, sp = 0u;
    for (;;) {
        sum = 0u; cnt = 0u; mine = 0u;
#pragma unroll
        for (unsigned j = 0; j < 16; ++j) { const unsigned c = xb_ld(&bar[XB_XCNT(j)]); sum += c; cnt += (c > 0u) ? 1u : 0u; mine = (j == x) ? c : mine; }
        if (sum == G) break;
        __builtin_amdgcn_s_sleep(1);
        if ((++sp & 255u) == 0u) { if (xb_ld(&bar[XB_TMO])) break; if (sp > XB_SPIN_CAP) { atomicAdd(&bar[XB_TMO], 1u); break; } }
    }
    nloc = mine > 0u ? mine : 1u; nx = cnt > 0u ? cnt : 1u;
}
__device__ __forceinline__ void xcd_barrier(const XcdBarrier& b) {
    asm volatile("s_waitcnt vmcnt(0)" ::: "memory");
    __syncthreads();
    if (threadIdx.x == 0) {
        unsigned* bar = b.bar;
        __builtin_amdgcn_s_waitcnt(0);
        unsigned nloc = b.st[0], nx = b.st[1];
        if (nloc == 0u) { xcd_barrier_complete(bar, b.x, nloc, nx); b.st[0] = nloc; b.st[1] = nx; }
        const unsigned old = xb_add(&bar[XB_XSUB(b.x)], 1u);
        const unsigned gen = old / nloc;
        if (old + 1u == (gen + 1u) * nloc) {
            __builtin_amdgcn_fence(__ATOMIC_RELEASE, "agent");
            asm volatile("s_waitcnt vmcnt(0)" ::: "memory");
            const unsigned og = xb_add(&bar[XB_TOP], 1u);
            const unsigned tg = og / nx;
            if (og + 1u == (tg + 1u) * nx) xb_add(&bar[XB_TOPGEN], 1u);
            else XB_SPIN(xb_ld(&bar[XB_TOPGEN]) == tg, bar);
            __builtin_amdgcn_fence(__ATOMIC_ACQUIRE, "agent");
            xb_add(&bar[XB_XGEN(b.x)], 1u);
            asm volatile("s_waitcnt vmcnt(0)" ::: "memory");
        } else {
            XB_SPIN(xb_ld(&bar[XB_XGEN(b.x)]) == gen, bar);
            __builtin_amdgcn_fence(__ATOMIC_ACQUIRE, "agent");
            asm volatile("s_waitcnt vmcnt(0)" ::: "memory");
        }
    }
    __syncthreads();
}

struct Frame {
    LAS unsigned char* lds;
    int tid, lane, wave, vcu, G;
    const float *xP, *xS, *spool, *cK, *cV, *cLF, *lng, *lnb, *w1, *w3, *w2, *poolw, *pools, *win, *bfg, *wo;
    float* out;
    bf16 *W13, *W2T, *WIN, *WO, *POOLT, *XBF, *HB, *DB, *QB, *KB, *VB, *VT, *OB;
    float *S, *CL;
};

__device__ __forceinline__ float wave_sum(float v) {
#pragma unroll
    for (int o = 1; o < 64; o <<= 1) v += __shfl_xor(v, o);
    return v;
}

__device__ __forceinline__ void p0_transpose_item(const float* W, int ldw, int Kd, bf16* WT, int k0, int n0, int drow0, LAS float* scr, int lane) {
#pragma unroll 8
    for (int i = 0; i < 32; ++i) { const int kk = 2 * i + (lane >> 5); scr[kk * 33 + (lane & 31)] = W[(size_t)(k0 + kk) * ldw + n0 + (lane & 31)]; }
    LDS_WAIT(); asm volatile("" ::: "memory");
    const int c = lane & 7;
#pragma unroll
    for (int j = 0; j < 4; ++j) { const int n = (lane >> 3) + 8 * j; const LAS float* s = scr + (8 * c) * 33 + n;
        v4u o; o.x = pk2(s[0 * 33], s[1 * 33]); o.y = pk2(s[2 * 33], s[3 * 33]); o.z = pk2(s[4 * 33], s[5 * 33]); o.w = pk2(s[6 * 33], s[7 * 33]);
        *(GAS v4u*)(WT + (size_t)(drow0 + n) * Kd + k0 + 8 * c) = o; }
    LDS_WAIT(); asm volatile("" ::: "memory");
}
__device__ __forceinline__ void p0_prologue(Frame& F) {
    LAS float* scr = (LAS float*)(F.lds + RING_OFF + F.wave * 16384);
    const int gw = F.vcu * NWAVES + F.wave, NGW = F.G * NWAVES;
    constexpr int I_UP = (D / 64) * (FF / 32);
    constexpr int I_DN = (FF / 64) * (D / 32);
    constexpr int I_IN = (D / 64) * (3 * D / 32);
    constexpr int I_WO = (D / 64) * (D / 32);
    constexpr int I_PL = 4 * (512 / 64) * (512 / 32);
    constexpr int NITEMS = 12 * 8192 + I_IN + I_WO + I_PL;
    static_assert(I_UP == 8192 && I_DN == 8192, "items");
    for (int it = gw; it < NITEMS; it += NGW) {
        int r = it;
        if (r < 8 * 8192) {
            const int mat = r >> 13, f = mat >> 1, which = mat & 1, q = r & 8191; const int nblk = FF / 32, kb = q / nblk, nb = q % nblk, n0 = 32 * nb;
            const float* W = (which ? F.w3 : F.w1) + (size_t)f * D * FF;
            p0_transpose_item(W, FF, D, F.W13 + (size_t)f * 2 * FF * D, 64 * kb, n0, 256 * (n0 >> 7) + (n0 & 127) + 128 * which, scr, F.lane); continue; }
        r -= 8 * 8192;
        if (r < 4 * 8192) { const int f = r >> 13, q = r & 8191; const int nblk = D / 32, kb = q / nblk, nb = q % nblk;
            p0_transpose_item(F.w2 + (size_t)f * FF * D, D, FF, F.W2T + (size_t)f * D * FF, 64 * kb, 32 * nb, 32 * nb, scr, F.lane); continue; }
        r -= 4 * 8192;
        if (r < I_IN) { const int nblk = 3 * D / 32, kb = r / nblk, nb = r % nblk;
            p0_transpose_item(F.win, WIN_LD, D, F.WIN, 64 * kb, 32 * nb, 32 * nb, scr, F.lane); continue; }
        r -= I_IN;
        if (r < I_WO) { const int nblk = D / 32, kb = r / nblk, nb = r % nblk;
            p0_transpose_item(F.wo, D, D, F.WO, 64 * kb, 32 * nb, 32 * nb, scr, F.lane); continue; }
        r -= I_WO;
        { const int g = r >> 7, q = r & 127, kb = q >> 4, nb = q & 15;
            p0_transpose_item(F.poolw + (size_t)g * 512 * 512, 512, 512, F.POOLT, 64 * kb, 32 * nb, g * 512 + 32 * nb, scr, F.lane); }
    }
    for (int m = gw; m < M; m += NGW) {
        const float* xrow = (m < SEQ) ? F.xP + (size_t)m * D : F.xS + (size_t)(m - SEQ) * D;
        const GAS f32x4* xr = (const GAS f32x4*)xrow + F.lane;
        GAS u32x2* o8 = (GAS u32x2*)(F.XBF + (size_t)m * D) + F.lane;
#pragma unroll
        for (int j = 0; j < 8; ++j) { const f32x4 v = xr[64 * j]; u32x2 w; w.x = pk2(v.x, v.y); w.y = pk2(v.z, v.w); o8[64 * j] = w; }
    }
}

template <bool WBF, bool WPOOL, bool LOGF, bool FINAL>
__device__ __forceinline__ void ln_pass(Frame& F, const float* g, const float* b) {
    const int gw = F.vcu * NWAVES + F.wave, NGW = F.G * NWAVES, lane = F.lane;
    LAS float* wft = (LAS float*)(F.lds + RING_OFF);
    if (LOGF) {
        for (int idx = F.tid; idx < D * NH; idx += NWAVES * 64) { const int c = idx >> 4, h = idx & 15; wft[h * D + c] = F.win[(size_t)c * WIN_LD + 3 * D + h]; }
        __syncthreads();
    }
    f32x4 gv[8], bv[8];
#pragma unroll
    for (int j = 0; j < 8; ++j) { gv[j] = ((const GAS f32x4*)g)[lane + 64 * j]; bv[j] = ((const GAS f32x4*)b)[lane + 64 * j]; }
    for (int row = gw; row < M; row += NGW) {
        float* srow = F.S + (size_t)row * D;
        f32x4 v[8]; float s = 0.f;
#pragma unroll
        for (int j = 0; j < 8; ++j) { v[j] = ((const GAS f32x4*)srow)[lane + 64 * j]; s += (v[j].x + v[j].y) + (v[j].z + v[j].w); }
        const float mean = wave_sum(s) * (1.f / D); float s2 = 0.f;
#pragma unroll
        for (int j = 0; j < 8; ++j) { v[j] = v[j] - mean; s2 += (v[j].x * v[j].x + v[j].y * v[j].y) + (v[j].z * v[j].z + v[j].w * v[j].w); }
        const float rstd = 1.f / sqrtf(wave_sum(s2) * (1.f / D) + LN_EPS);
#pragma unroll
        for (int j = 0; j < 8; ++j) v[j] = v[j] * rstd * gv[j] + bv[j];
        if (FINAL) {
            float* orow = (row < SEQ) ? F.out + O_YP + (size_t)row * D : F.out + O_YS + (size_t)(row - SEQ) * D;
#pragma unroll
            for (int j = 0; j < 8; ++j) ((GAS f32x4*)orow)[lane + 64 * j] = v[j];
        } else {
#pragma unroll
            for (int j = 0; j < 8; ++j) ((GAS f32x4*)srow)[lane + 64 * j] = v[j];
        }
        if (WBF) {
            GAS u32x2* o8 = (GAS u32x2*)(F.XBF + (size_t)row * D) + lane;
#pragma unroll
            for (int j = 0; j < 8; ++j) { u32x2 w; w.x = pk2(v[j].x, v[j].y); w.y = pk2(v[j].z, v[j].w); o8[64 * j] = w; }
        }
        if (WPOOL) {
            float* prow = nullptr;
            if (row >= SEQ - PST && row < SEQ) prow = F.out + O_PP + (size_t)(row - (SEQ - PST)) * D;
            else if (row >= SEQ) { const int bb = (row - SEQ) >> 4, i = (row - SEQ) & 15; if (i >= 1) prow = F.out + O_PS + ((size_t)bb * PST + (i - 1)) * D; }
            if (prow) {
#pragma unroll
                for (int j = 0; j < 8; ++j) ((GAS f32x4*)prow)[lane + 64 * j] = v[j];
            }
        }
        if (LOGF) {
            float mine = 0.f;
#pragma unroll 1
            for (int h = 0; h < NH; ++h) {
                float p = 0.f;
#pragma unroll
                for (int j = 0; j < 8; ++j) { const f32x4 w = *(const LAS f32x4*)(wft + h * D + 4 * lane + 256 * j); p += (v[j].x * w.x + v[j].y * w.y) + (v[j].z * w.z + v[j].w * w.w); }
                p = wave_sum(p);
                mine = (lane == h) ? p : mine;
            }
            if (lane < NH) {
                const float z = mine + F.bfg[lane];
                const float lf = (z >= 0.f) ? -log1pf(expf(-z)) : (z - log1pf(expf(z)));
                float* lp = (row < SEQ) ? F.out + O_LP + (size_t)row * NH : F.out + O_LS + (size_t)(row - SEQ) * NH;
                lp[lane] = lf;
            }
        }
    }
    if (LOGF) __syncthreads();
}

__device__ __forceinline__ f32x4 pool_fetch(Frame& F, int kind, int b, int idx, int c4) {
    if (kind == 0) { if (idx < 0) return (f32x4){0.f, 0.f, 0.f, 0.f}; return *(const GAS f32x4*)(F.S + (size_t)idx * D + c4); }
    if (idx < PST) return *(const GAS f32x4*)(F.spool + ((size_t)b * PST + idx) * D + c4);
    return *(const GAS f32x4*)(F.S + (size_t)(SEQ + b * DECT + idx - PST) * D + c4);
}
__device__ __forceinline__ void pool_pass(Frame& F) {
    const int c4 = 4 * F.tid, grp = F.tid >> 7, w = 2 << grp;
    constexpr int NRUN_P = SEQ / 8, NRUN = NRUN_P + DECB * 2;
    for (int run = F.vcu; run < NRUN; run += F.G) {
        int kind, b, i0, orow0;
        if (run < NRUN_P) { kind = 0; b = 0; i0 = run * 8; orow0 = i0; }
        else { const int r = run - NRUN_P; kind = 1; b = r >> 1; i0 = PST + (r & 1) * 8; orow0 = SEQ + b * DECT + (r & 1) * 8; }
        f32x4 acc = (f32x4){0.f, 0.f, 0.f, 0.f};
        for (int j = 1; j < w; ++j) acc = acc + pool_fetch(F, kind, b, i0 - j, c4);
#pragma unroll
        for (int e = 0; e < 8; ++e) {
            const int i = i0 + e;
            const f32x4 x = pool_fetch(F, kind, b, i, c4);
            acc = acc + x;
            const int cnti = (kind == 0) ? ((i + 1 < w) ? i + 1 : w) : w;
            const float cnt = (float)cnti;
            const f32x4 d = acc / cnt - x;
            u32x2 o; o.x = pk2(d.x, d.y); o.y = pk2(d.z, d.w);
            *(GAS u32x2*)(F.DB + (size_t)(orow0 + e) * D + c4) = o;
            acc = acc - pool_fetch(F, kind, b, i - w + 1, c4);
        }
    }
}

__device__ __forceinline__ float block_excl_scan(float v, LAS float* buf, int tid) {
    buf[tid] = v; __syncthreads();
    int src = 0;
    for (int off = 1; off < 512; off <<= 1) {
        float x = buf[src * 512 + tid]; if (tid >= off) x += buf[src * 512 + tid - off];
        buf[(src ^ 1) * 512 + tid] = x; __syncthreads(); src ^= 1;
    }
    const float incl = buf[src * 512 + tid]; __syncthreads();
    return incl - v;
}

__device__ __forceinline__ void scan_vt_pass(Frame& F) {
    if (F.vcu < NH) {
        const int h = F.vcu; const float* lf = F.out + O_LP;
        LAS float* buf = (LAS float*)(F.lds + RING_OFF);
        const int t0 = 32 * F.tid; float tot = 0.f;
#pragma unroll 8
        for (int e = 0; e < 32; ++e) tot += lf[(size_t)(t0 + e) * NH + h];
        float run = block_excl_scan(tot, buf, F.tid);
#pragma unroll 8
        for (int e = 0; e < 32; ++e) { run += lf[(size_t)(t0 + e) * NH + h]; F.CL[(size_t)h * SEQ + t0 + e] = run * LOG2E; }
        __syncthreads();
    }
    LAS unsigned* T = (LAS unsigned*)(F.lds + RING_OFF);
    constexpr int NIT = NH * (SEQ / 64);
    for (int it = F.vcu; it < NIT; it += F.G) {
        const int h = it & 15, sb = it >> 4, s0 = sb * 64;
#pragma unroll
        for (int i = 0; i < 2; ++i) { const int cidx = F.tid + 512 * i, s = cidx >> 4, dc = cidx & 15;
            const u32x4 v = *(const GAS u32x4*)(F.VB + (size_t)(s0 + s) * D + h * DH + 8 * dc);
            LAS unsigned* p = T + s * 65 + 4 * dc; p[0] = v.x; p[1] = v.y; p[2] = v.z; p[3] = v.w; }
        __syncthreads();
#pragma unroll
        for (int i = 0; i < 2; ++i) { const int cidx = F.tid + 512 * i, d = cidx >> 3, sc = cidx & 7;
            const LAS unsigned short* ps = (const LAS unsigned short*)T + d;
            unsigned e[8];
#pragma unroll
            for (int j = 0; j < 8; ++j) e[j] = ps[(size_t)(8 * sc + j) * 130];
            u32x4 o; o.x = e[0] | (e[1] << 16); o.y = e[2] | (e[3] << 16); o.z = e[4] | (e[5] << 16); o.w = e[6] | (e[7] << 16);
            *(GAS u32x4*)(F.VT + ((size_t)h * DH + d) * SEQ + s0 + 8 * sc) = o; }
        __syncthreads();
    }
}

#define MFMA32(a, b, c) __builtin_amdgcn_mfma_f32_32x32x16_bf16((a), (b), (c), 0, 0, 0)
__device__ __forceinline__ int kswz(int row, int colB) { return row * 256 + (colB ^ ((row & 7) << 4)); }
constexpr int AT_K = 0, AT_V = 32768, AT_C = 65536;

__device__ __forceinline__ void attn_prompt_unit(Frame& F, int h, int qb) {
    LAS unsigned char* lds = F.lds + RING_OFF;
    const int tid = F.tid, w = F.wave, lane = F.lane, c = lane & 31, hh = lane >> 5;
    const int q0 = 256 * qb + 32 * w, qrow = q0 + c;
    bf16x8 qf[8];
    { const bf16* Qp = F.QB + (size_t)qrow * D + h * DH + 8 * hh;
#pragma unroll
      for (int ch = 0; ch < 8; ++ch) qf[ch] = *(const GAS bf16x8*)(Qp + 16 * ch); }
    const float cq = F.CL[(size_t)h * SEQ + qrow];
    f32x16 o[4];
#pragma unroll
    for (int db = 0; db < 4; ++db)
#pragma unroll
        for (int i = 0; i < 16; ++i) o[db][i] = 0.f;
    float m = -1e30f, lsum = 0.f;
    const int ntiles = 4 * qb + 4, tmax = 4 * qb + (w >> 1);
    const int kr0 = tid >> 4, kc = tid & 15;
    const int vd0 = tid >> 3, vc = tid & 7;
    const unsigned char* wsb = (const unsigned char*)F.S - WS_S;
    const unsigned koff = (unsigned)WS_KB + (unsigned)((kr0 * D + h * DH + 8 * kc) * 2);
    const unsigned voff = (unsigned)WS_VT + (unsigned)(((h * DH + vd0) * SEQ + 8 * vc) * 2);
    const unsigned coff = (unsigned)WS_CL + (unsigned)((h * SEQ + (tid & 63)) * 4);
    u32x4 kst[2], vst[2]; float cst = 0.f;
#define AT_LOAD(kt) do { const unsigned _k0 = 64u * (unsigned)(kt); \
        kst[0] = *(const GAS u32x4*)(wsb + (koff + _k0 * (D * 2))); kst[1] = *(const GAS u32x4*)(wsb + (koff + _k0 * (D * 2) + 32 * D * 2)); \
        vst[0] = *(const GAS u32x4*)(wsb + (voff + _k0 * 2)); vst[1] = *(const GAS u32x4*)(wsb + (voff + _k0 * 2 + 64 * SEQ * 2)); \
        if (tid < 64) cst = *(const GAS float*)(wsb + (coff + _k0 * 4)); } while (0)
#define AT_WRITE(buf) do { LAS unsigned char* _kb = lds + AT_K + (buf) * 16384; LAS unsigned char* _vb = lds + AT_V + (buf) * 16384; \
        *(LAS u32x4*)(_kb + kswz(kr0, 16 * kc)) = kst[0]; *(LAS u32x4*)(_kb + kswz(kr0 + 32, 16 * kc)) = kst[1]; \
        { const int _f = (vd0 >> 1) & 15; LAS unsigned char* _r = _vb + vd0 * 128; \
          *(LAS u32x2*)(_r + (((2 * vc) ^ _f) << 3)) = (u32x2){vst[0].x, vst[0].y}; *(LAS u32x2*)(_r + (((2 * vc + 1) ^ _f) << 3)) = (u32x2){vst[0].z, vst[0].w}; } \
        { const int _d = vd0 + 64, _f = (_d >> 1) & 15; LAS unsigned char* _r = _vb + _d * 128; \
          *(LAS u32x2*)(_r + (((2 * vc) ^ _f) << 3)) = (u32x2){vst[1].x, vst[1].y}; *(LAS u32x2*)(_r + (((2 * vc + 1) ^ _f) << 3)) = (u32x2){vst[1].z, vst[1].w}; } \
        if (tid < 64) *(LAS float*)(lds + AT_C + (buf) * 256 + tid * 4) = cst; } while (0)
    AT_LOAD(0); AT_WRITE(0); __syncthreads();
    for (int kt = 0; kt < ntiles; ++kt) {
        const int buf = kt & 1;
        if (kt + 1 < ntiles) AT_LOAD(kt + 1);
        if (kt <= tmax) {
            const LAS unsigned char* Kb = lds + AT_K + buf * 16384; const LAS unsigned char* Vb = lds + AT_V + buf * 16384; const LAS unsigned char* Cb = lds + AT_C + buf * 256;
            f32x16 s0, s1;
#pragma unroll
            for (int i = 0; i < 16; ++i) { s0[i] = 0.f; s1[i] = 0.f; }
            const LAS unsigned char* Kr = Kb + c * 256;
            const int kx = (c & 7) << 4;
#pragma unroll
            for (int ch = 0; ch < 8; ++ch) {
                const int co = ((32 * (ch & 3) + 16 * hh) ^ kx) + 128 * (ch >> 2);
                const bf16x8 k0 = *(const LAS bf16x8*)(Kr + co);
                const bf16x8 k1 = *(const LAS bf16x8*)(Kr + co + 8192);
                s0 = MFMA32(k0, qf[ch], s0); s1 = MFMA32(k1, qf[ch], s1);
                if (ch & 1) __builtin_amdgcn_sched_barrier(0);
            }
#pragma unroll
            for (int g = 0; g < 4; ++g) {
                const f32x4 cb0 = *(const LAS f32x4*)(Cb + (8 * g + 4 * hh) * 4), cb1 = *(const LAS f32x4*)(Cb + (32 + 8 * g + 4 * hh) * 4);
#pragma unroll
                for (int e = 0; e < 4; ++e) { s0[4 * g + e] += cq - cb0[e]; s1[4 * g + e] += cq - cb1[e]; }
            }
            if (64 * kt + 63 > q0) {
#pragma unroll
                for (int i = 0; i < 16; ++i) { const int key = 64 * kt + (i & 3) + 8 * (i >> 2) + 4 * hh;
                    if (key > qrow) s0[i] = -INFINITY; if (key + 32 > qrow) s1[i] = -INFINITY; }
            }
            float mx = s0[0];
#pragma unroll
            for (int i = 1; i < 16; ++i) mx = fmaxf(mx, s0[i]);
#pragma unroll
            for (int i = 0; i < 16; ++i) mx = fmaxf(mx, s1[i]);
            mx = fmaxf(mx, __shfl_xor(mx, 32));
            const float mnew = fmaxf(m, mx), alpha = __builtin_amdgcn_exp2f(m - mnew); m = mnew;
            float ps = 0.f;
#pragma unroll
            for (int i = 0; i < 16; ++i) { s0[i] = __builtin_amdgcn_exp2f(s0[i] - mnew); s1[i] = __builtin_amdgcn_exp2f(s1[i] - mnew); ps += s0[i] + s1[i]; }
            lsum = lsum * alpha + ps;
#pragma unroll
            for (int db = 0; db < 4; ++db)
#pragma unroll
                for (int i = 0; i < 16; ++i) o[db][i] *= alpha;
            bf16x8 pf[2][2];
#pragma unroll
            for (int s2 = 0; s2 < 2; ++s2) {
                u32x4 a, b;
                a.x = cvtpk(s0[8 * s2 + 0], s0[8 * s2 + 1]); a.y = cvtpk(s0[8 * s2 + 2], s0[8 * s2 + 3]); a.z = cvtpk(s0[8 * s2 + 4], s0[8 * s2 + 5]); a.w = cvtpk(s0[8 * s2 + 6], s0[8 * s2 + 7]);
                b.x = cvtpk(s1[8 * s2 + 0], s1[8 * s2 + 1]); b.y = cvtpk(s1[8 * s2 + 2], s1[8 * s2 + 3]); b.z = cvtpk(s1[8 * s2 + 4], s1[8 * s2 + 5]); b.w = cvtpk(s1[8 * s2 + 6], s1[8 * s2 + 7]);
                pf[0][s2] = __builtin_bit_cast(bf16x8, a); pf[1][s2] = __builtin_bit_cast(bf16x8, b);
            }
#pragma unroll
            for (int db = 0; db < 4; ++db) {
                const int f = (c >> 1) & 15; const LAS unsigned char* rowb = Vb + c * 128 + db * 4096;
#pragma unroll
                for (int kb = 0; kb < 2; ++kb)
#pragma unroll
                    for (int s2 = 0; s2 < 2; ++s2) {
                        const int g0 = 8 * kb + 4 * s2 + hh;
                        const u32x2 lo = *(const LAS u32x2*)(rowb + ((g0 ^ f) << 3)), hi = *(const LAS u32x2*)(rowb + (((g0 + 2) ^ f) << 3));
                        const u32x4 vv = (u32x4){lo.x, lo.y, hi.x, hi.y};
                        o[db] = MFMA32(__builtin_bit_cast(bf16x8, vv), pf[kb][s2], o[db]);
                    }
                __builtin_amdgcn_sched_barrier(0);
            }
        }
        if (kt + 1 < ntiles) AT_WRITE(buf ^ 1);
        __syncthreads();
    }
#undef AT_LOAD
#undef AT_WRITE
    const float ltot = lsum + __shfl_xor(lsum, 32), inv = 1.0f / ltot;
    bf16* Op = F.OB + (size_t)qrow * D + h * DH;
#pragma unroll
    for (int db = 0; db < 4; ++db)
#pragma unroll
        for (int g = 0; g < 4; ++g) {
            u32x2 wv; wv.x = cvtpk(o[db][4 * g] * inv, o[db][4 * g + 1] * inv); wv.y = cvtpk(o[db][4 * g + 2] * inv, o[db][4 * g + 3] * inv);
            *(GAS u32x2*)(Op + 32 * db + 8 * g + 4 * hh) = wv;
        }
}

constexpr int SA_CS = 0;
constexpr int SA_SCAN = 8448;
constexpr int SA_P = 12800;
constexpr int SA_A = 29184;
constexpr int SA_M = 29696, SA_L = 30208;
constexpr int SA_O = 32768;
__device__ __forceinline__ void attn_sample_unit(Frame& F, int b, int h) {
    LAS unsigned char* lds = F.lds + RING_OFF;
    const int tid = F.tid, w = F.wave, lane = F.lane, c = lane & 31, hh = lane >> 5, qi = c & 15;
    LAS float* cs = (LAS float*)(lds + SA_CS);
    {
        const float* lf = F.cLF + ((size_t)b * PAST) * NH + h;
        float v[4], tot = 0.f;
#pragma unroll
        for (int e = 0; e < 4; ++e) { v[e] = lf[(size_t)(4 * tid + e) * NH]; tot += v[e]; }
        float run = block_excl_scan(tot, (LAS float*)(lds + SA_SCAN), tid);
#pragma unroll
        for (int e = 0; e < 4; ++e) { run += v[e]; cs[4 * tid + e] = run * LOG2E; }
        __syncthreads();
        if (tid == 0) { float r = cs[PAST - 1]; const float* ln = F.out + O_LS + (size_t)(b * DECT) * NH + h;
            for (int i = 0; i < DECT; ++i) { r += ln[(size_t)i * NH] * LOG2E; cs[PAST + i] = r; }
            for (int i = DECT; i < 32; ++i) cs[PAST + i] = r; }
        __syncthreads();
    }
    bf16x8 qf[8];
    { const bf16* Qp = F.QB + (size_t)(SEQ + b * DECT + qi) * D + h * DH + 8 * hh;
#pragma unroll
      for (int ch = 0; ch < 8; ++ch) { bf16x8 t = *(const GAS bf16x8*)(Qp + 16 * ch); if (c >= 16) t = (bf16x8){0, 0, 0, 0, 0, 0, 0, 0}; qf[ch] = t; } }
    const float cq = cs[PAST + qi];
    float m = -1e30f, lsum = 0.f;
    float oa[16][2];
#pragma unroll
    for (int q = 0; q < 16; ++q) { oa[q][0] = 0.f; oa[q][1] = 0.f; }
    LAS float* Pw = (LAS float*)(lds + SA_P + w * 2048);
    LAS float* Aw = (LAS float*)(lds + SA_A + w * 64);
    for (int T = w; T < 65; T += NWAVES) {
        f32x16 s;
#pragma unroll
        for (int i = 0; i < 16; ++i) s[i] = 0.f;
        if (T < 64) {
            const float* kp = F.cK + (((size_t)b * PAST + 32 * T + c) * NH + h) * DH + 8 * hh;
#pragma unroll
            for (int ch = 0; ch < 8; ++ch) { const f32x4 a = *(const GAS f32x4*)(kp + 16 * ch), bb = *(const GAS f32x4*)(kp + 16 * ch + 4);
                u32x4 kk; kk.x = cvtpk(a.x, a.y); kk.y = cvtpk(a.z, a.w); kk.z = cvtpk(bb.x, bb.y); kk.w = cvtpk(bb.z, bb.w);
                s = MFMA32(__builtin_bit_cast(bf16x8, kk), qf[ch], s); }
        } else {
            const bf16* kp = F.KB + (size_t)(SEQ + b * DECT + qi) * D + h * DH + 8 * hh;
#pragma unroll
            for (int ch = 0; ch < 8; ++ch) { bf16x8 kk = *(const GAS bf16x8*)(kp + 16 * ch); if (c >= 16) kk = (bf16x8){0, 0, 0, 0, 0, 0, 0, 0};
                s = MFMA32(kk, qf[ch], s); }
        }
#pragma unroll
        for (int g = 0; g < 4; ++g) { const f32x4 cb = *(const LAS f32x4*)(cs + 32 * T + 8 * g + 4 * hh);
#pragma unroll
            for (int e = 0; e < 4; ++e) s[4 * g + e] += cq - cb[e]; }
        if (T == 64) {
#pragma unroll
            for (int i = 0; i < 16; ++i) { const int kl = (i & 3) + 8 * (i >> 2) + 4 * hh; if (kl > qi) s[i] = -INFINITY; }
        }
        float mx = s[0];
#pragma unroll
        for (int i = 1; i < 16; ++i) mx = fmaxf(mx, s[i]);
        mx = fmaxf(mx, __shfl_xor(mx, 32));
        const float mnew = fmaxf(m, mx), alpha = __builtin_amdgcn_exp2f(m - mnew); m = mnew;
        float ps = 0.f;
#pragma unroll
        for (int i = 0; i < 16; ++i) { s[i] = __builtin_amdgcn_exp2f(s[i] - mnew); ps += s[i]; }
        lsum = lsum * alpha + ps;
        if (c < 16) {
#pragma unroll
            for (int i = 0; i < 16; ++i) { const int kl = (i & 3) + 8 * (i >> 2) + 4 * hh; Pw[kl * 16 + c] = s[i]; }
            if (hh == 0) Aw[c] = alpha;
        }
        asm volatile("s_waitcnt lgkmcnt(0)" ::: "memory"); __builtin_amdgcn_wave_barrier();
        {
            f32x4 a4[4];
#pragma unroll
            for (int j = 0; j < 4; ++j) a4[j] = *(const LAS f32x4*)(Aw + 4 * j);
#pragma unroll
            for (int q = 0; q < 16; ++q) { oa[q][0] *= a4[q >> 2][q & 3]; oa[q][1] *= a4[q >> 2][q & 3]; }
        }
        if (T < 64) {
            const float* vp = F.cV + (((size_t)b * PAST + 32 * T) * NH + h) * DH + 2 * lane;
#pragma unroll 4
            for (int kl = 0; kl < 32; ++kl) {
                const f32x2 v2 = *(const GAS f32x2*)(vp + (size_t)kl * NH * DH);
                f32x4 p4[4];
#pragma unroll
                for (int j = 0; j < 4; ++j) p4[j] = *(const LAS f32x4*)(Pw + kl * 16 + 4 * j);
#pragma unroll
                for (int q = 0; q < 16; ++q) { const float p = p4[q >> 2][q & 3]; oa[q][0] += p * v2.x; oa[q][1] += p * v2.y; }
            }
        } else {
            const bf16* vp = F.VB + (size_t)(SEQ + b * DECT) * D + h * DH + 2 * lane;
#pragma unroll 4
            for (int kl = 0; kl < 16; ++kl) {
                const unsigned vw = *(const GAS unsigned*)(vp + (size_t)kl * D);
                const float vx = bf_lo(vw), vy = bf_hi(vw);
                f32x4 p4[4];
#pragma unroll
                for (int j = 0; j < 4; ++j) p4[j] = *(const LAS f32x4*)(Pw + kl * 16 + 4 * j);
#pragma unroll
                for (int q = 0; q < 16; ++q) { const float p = p4[q >> 2][q & 3]; oa[q][0] += p * vx; oa[q][1] += p * vy; }
            }
        }
        asm volatile("s_waitcnt lgkmcnt(0)" ::: "memory"); __builtin_amdgcn_wave_barrier();
    }
    {
        const float ltot = lsum + __shfl_xor(lsum, 32);
        LAS float* Mb = (LAS float*)(lds + SA_M); LAS float* Lb = (LAS float*)(lds + SA_L); LAS float* Ob = (LAS float*)(lds + SA_O);
        if (lane < 16) { Mb[w * 16 + lane] = m; Lb[w * 16 + lane] = ltot; }
#pragma unroll
        for (int q = 0; q < 16; ++q) *(LAS f32x2*)(Ob + (w * 16 + q) * 128 + 2 * lane) = (f32x2){oa[q][0], oa[q][1]};
        __syncthreads();
#pragma unroll
        for (int i = 0; i < 4; ++i) {
            const int idx = tid + 512 * i, q = idx >> 7, d = idx & 127;
            float mx = Mb[q];
#pragma unroll
            for (int ww = 1; ww < 8; ++ww) mx = fmaxf(mx, Mb[ww * 16 + q]);
            float L = 0.f, ov = 0.f;
#pragma unroll
            for (int ww = 0; ww < 8; ++ww) { const float sc = __builtin_amdgcn_exp2f(Mb[ww * 16 + q] - mx); L += Lb[ww * 16 + q] * sc; ov += Ob[(ww * 16 + q) * 128 + d] * sc; }
            F.OB[(size_t)(SEQ + b * DECT + q) * D + h * DH + d] = (bf16)f2bf(ov / L);
        }
        __syncthreads();
    }
}

constexpr int NPHASE = 21;
struct Args { const float* in[16]; float* out; unsigned char* ws; int ph_lo, ph_hi; };
__global__ void __launch_bounds__(NWAVES * 64, 2) trunk_fwd(Args args) {
    extern __shared__ __attribute__((aligned(16))) unsigned char lds[];
    Frame F;
    F.lds = (LAS unsigned char*)lds;
    F.tid = threadIdx.x; F.lane = F.tid & 63; F.wave = __builtin_amdgcn_readfirstlane(F.tid >> 6);
    F.G = gridDim.x; { const int bx = blockIdx.x; F.vcu = (F.G % 8 == 0) ? (bx % 8) * (F.G / 8) + bx / 8 : bx; }
    unsigned char* ws = args.ws;
    F.xP = args.in[0]; F.xS = args.in[1]; F.spool = args.in[2]; F.cK = args.in[3]; F.cV = args.in[4]; F.cLF = args.in[5]; F.lng = args.in[6]; F.lnb = args.in[7];
    F.w1 = args.in[8]; F.w3 = args.in[9]; F.w2 = args.in[10]; F.poolw = args.in[11]; F.pools = args.in[12]; F.win = args.in[13]; F.bfg = args.in[14]; F.wo = args.in[15];
    F.out = args.out;
    F.W13 = (bf16*)(ws + WS_W13); F.W2T = (bf16*)(ws + WS_W2T); F.WIN = (bf16*)(ws + WS_WIN); F.WO = (bf16*)(ws + WS_WO); F.POOLT = (bf16*)(ws + WS_POOLT);
    F.S = (float*)(ws + WS_S); F.XBF = (bf16*)(ws + WS_XBF); F.HB = (bf16*)(ws + WS_HB); F.DB = (bf16*)(ws + WS_DB);
    F.QB = (bf16*)(ws + WS_QB); F.KB = (bf16*)(ws + WS_KB); F.VB = (bf16*)(ws + WS_VB); F.VT = (bf16*)(ws + WS_VT); F.OB = (bf16*)(ws + WS_OB); F.CL = (float*)(ws + WS_CL);
    for (int u = F.tid; u < (LDS_BYTES - LDSCTL_OFF) / 4; u += NWAVES * 64) ((LAS unsigned*)(F.lds + LDSCTL_OFF))[u] = 0u;
    __syncthreads();
    volatile LAS unsigned* MISC = (volatile LAS unsigned*)(F.lds + MISC_OFF);
    XcdBarrier bar; bar.bar = (unsigned*)(ws + WS_CTL) + CW_BAR; bar.x = 0; bar.st = nullptr;
    if (!MK_SPLIT) bar = xcd_barrier_post((unsigned*)(ws + WS_CTL) + CW_BAR, MISC + 8);
    const int lo = args.ph_lo, hi = args.ph_hi;
#ifdef ONLY_PHASE
#define IN(k) ((k) == ONLY_PHASE && lo <= (k) && (k) < hi)
#else
#define IN(k) (lo <= (k) && (k) < hi)
#endif
#define SEAM(k) do { if (IN(k) && IN((k) + 1)) xcd_barrier(bar); } while (0)
#define UP_PHASE(k, f) if (IN(k)) { pg8::Gemm g{F.XBF, F.W13 + (size_t)(f) * 2 * FF * D, D, D, D}; pg8::StaticOrder S; S.init(M, 2 * FF, F.G, (int)blockIdx.x); \
        pg8::EpiSwiglu E{F.HB}; pg8::gemm_phase<pg8::EpiSwiglu, pg8::StaticOrder>(F.lds + RING_OFF, g, S, E); } SEAM(k)
#define DOWN_PHASE(k, f, sp, ss) if (IN(k)) { pg8::Gemm g{F.HB, F.W2T + (size_t)(f) * D * FF, FF, FF, FF}; pg8::StaticOrder S; S.init(M, D, F.G, (int)blockIdx.x); \
        pg8::EpiResid E{F.S, (sp), (ss), 0.5f, nullptr}; pg8::gemm_phase<pg8::EpiResid, pg8::StaticOrder>(F.lds + RING_OFF, g, S, E); } SEAM(k)

    if (IN(0)) { p0_prologue(F); } SEAM(0);
    UP_PHASE(1, 0);
    DOWN_PHASE(2, 0, F.xP, F.xS);
    if (IN(3)) { ln_pass<false, true, false, false>(F, F.lng + 0 * D, F.lnb + 0 * D); } SEAM(3);
    if (IN(4)) { pool_pass(F); } SEAM(4);
    if (IN(5)) { pg8::Gemm g{F.DB, F.POOLT, D, 512, 512}; pg8::StaticOrder S; S.init(M, D, F.G, (int)blockIdx.x, 2, 512 * 2);
        pg8::EpiResid E{F.S, F.S, F.S + (size_t)SEQ * D, 1.0f, F.pools}; pg8::gemm_phase<pg8::EpiResid, pg8::StaticOrder>(F.lds + RING_OFF, g, S, E); } SEAM(5);
    if (IN(6)) { ln_pass<true, false, false, false>(F, F.lng + 1 * D, F.lnb + 1 * D); } SEAM(6);
    UP_PHASE(7, 1);
    DOWN_PHASE(8, 1, F.S, F.S + (size_t)SEQ * D);
    if (IN(9)) { ln_pass<true, false, false, false>(F, F.lng + 2 * D, F.lnb + 2 * D); } SEAM(9);
    UP_PHASE(10, 2);
    DOWN_PHASE(11, 2, F.S, F.S + (size_t)SEQ * D);
    if (IN(12)) { ln_pass<true, false, true, false>(F, F.lng + 3 * D, F.lnb + 3 * D); } SEAM(12);
    if (IN(13)) { pg8::Gemm g{F.XBF, F.WIN, D, D, D}; pg8::StaticOrder S; S.init(M, 3 * D, F.G, (int)blockIdx.x);
        pg8::EpiQKV E{F.QB, (size_t)(WS_KB - WS_QB) / 2, F.out + O_KP, F.out + O_KS}; pg8::gemm_phase<pg8::EpiQKV, pg8::StaticOrder>(F.lds + RING_OFF, g, S, E); } SEAM(13);
    if (IN(14)) { scan_vt_pass(F); } SEAM(14);
    if (IN(15)) {
#if !defined(ATT_ONLY) || ATT_ONLY == 1
        for (int p = F.vcu; p < NH * 32; p += F.G) { const int h = p >> 5, x = p & 31;
            for (int half = 0; half < 2; ++half) attn_prompt_unit(F, h, half ? 63 - x : x); }
#endif
#if !defined(ATT_ONLY) || ATT_ONLY == 2
        for (int u = F.vcu; u < DECB * NH; u += F.G) attn_sample_unit(F, u >> 4, u & 15);
#endif
    } SEAM(15);
    if (IN(16)) { pg8::Gemm g{F.OB, F.WO, D, D, D}; pg8::StaticOrder S; S.init(M, D, F.G, (int)blockIdx.x);
        pg8::EpiResid E{F.S, F.S, F.S + (size_t)SEQ * D, 1.0f, nullptr}; pg8::gemm_phase<pg8::EpiResid, pg8::StaticOrder>(F.lds + RING_OFF, g, S, E); } SEAM(16);
    if (IN(17)) { ln_pass<true, false, false, false>(F, F.lng + 4 * D, F.lnb + 4 * D); } SEAM(17);
    UP_PHASE(18, 3);
    DOWN_PHASE(19, 3, F.S, F.S + (size_t)SEQ * D);
    if (IN(20)) { ln_pass<false, false, false, true>(F, F.lng + 5 * D, F.lnb + 5 * D); }
#undef IN
#undef SEAM
#undef UP_PHASE
#undef DOWN_PHASE
}

extern "C" void kernel_launch(void* const* d_in, const int* in_sizes, int n_in, void* d_out, int out_size, void* d_ws, size_t ws_size, hipStream_t stream) {
    static int grid = 0;
    if (grid == 0) {
        if (n_in != 16 || (size_t)out_size != O_END || ws_size < WS_END) { fprintf(stderr, "kernel_launch: unexpected shapes (n_in %d, out %d, ws %zu)\n", n_in, out_size, ws_size); grid = -1; return; }
        int dev = 0, cus = 0, per_cu = 0;
        if (hipGetDevice(&dev) != hipSuccess || hipDeviceGetAttribute(&cus, hipDeviceAttributeMultiprocessorCount, dev) != hipSuccess) { grid = -1; return; }
        if (hipFuncSetAttribute((const void*)trunk_fwd, hipFuncAttributeMaxDynamicSharedMemorySize, LDS_BYTES) != hipSuccess) { fprintf(stderr, "kernel_launch: hipFuncSetAttribute failed\n"); grid = -1; return; }
        if (hipOccupancyMaxActiveBlocksPerMultiprocessor(&per_cu, (const void*)trunk_fwd, NWAVES * 64, LDS_BYTES) != hipSuccess || per_cu < 1)
            fprintf(stderr, "kernel_launch: occupancy query reports %d workgroups per CU\n", per_cu);
        (void)hipGetLastError();
        grid = cus;
    }
    if (grid < 0) return;
    (void)hipMemsetAsync((char*)d_ws + WS_CTL, 0, CTL_ZERO_BYTES, stream);
    Args a{};
    for (int i = 0; i < 16; ++i) a.in[i] = (const float*)d_in[i];
    a.out = (float*)d_out; a.ws = (unsigned char*)d_ws;
#if MK_SPLIT
    for (int k = 0; k < NPHASE; ++k) { a.ph_lo = k; a.ph_hi = k + 1; hipLaunchKernelGGL(trunk_fwd, dim3(grid), dim3(NWAVES * 64), LDS_BYTES, stream, a); }
#else
    a.ph_lo = 0; a.ph_hi = NPHASE; hipLaunchKernelGGL(trunk_fwd, dim3(grid), dim3(NWAVES * 64), LDS_BYTES, stream, a);
#endif
}
```

```cpp
#include <hip/hip_runtime.h>
#include <cstdio>
#include <cstdint>

#ifndef MK_SPLIT
#define MK_SPLIT 0
#endif

#define LAS __attribute__((address_space(3)))
#define GAS __attribute__((address_space(1)))
typedef unsigned short bf16;
typedef short bf16x8 __attribute__((ext_vector_type(8)));
typedef float f32x4 __attribute__((ext_vector_type(4)));
typedef float f32x2 __attribute__((ext_vector_type(2)));
typedef float f32x16 __attribute__((ext_vector_type(16)));
typedef unsigned u32x4 __attribute__((ext_vector_type(4)));
typedef unsigned u32x2 __attribute__((ext_vector_type(2)));
typedef unsigned v4u __attribute__((ext_vector_type(4)));
typedef __bf16 bf16x2_t __attribute__((ext_vector_type(2)));

constexpr int D = 2048, SEQ = 16384, NS = 512, M = SEQ + NS, FF = 8192, NH = 16, DH = 128, PAST = 2048, DECB = 32, DECT = 16, PST = 15;
constexpr int WIN_LD = 3 * D + NH;
constexpr float ALPHA = 1.41421356237309515f, LN_EPS = 1e-5f;
constexpr float LOG2E = 1.4426950408889634f;
constexpr float QSCALE = 0.08838834764831845f * 1.4426950408889634f;

constexpr size_t O_YP = 0, O_YS = 33554432, O_PP = 34603008, O_PS = 34633728, O_KP = 35616768, O_VP = 69171200, O_LP = 102725632, O_KS = 102987776, O_VS = 104036352, O_LS = 105084928, O_END = 105093120;

constexpr size_t MiB = 1u << 20;
constexpr size_t WS_CTL = 0, CTL_ZERO_BYTES = 1 * MiB;
constexpr size_t WS_W13 = 2 * MiB;
constexpr size_t WS_W2T = 258 * MiB;
constexpr size_t WS_WIN = 386 * MiB;
constexpr size_t WS_WO = 410 * MiB;
constexpr size_t WS_POOLT = 418 * MiB;
constexpr size_t WS_S = 420 * MiB;
constexpr size_t WS_XBF = 552 * MiB;
constexpr size_t WS_HB = 618 * MiB;
constexpr size_t WS_DB = 882 * MiB;
constexpr size_t WS_QB = 948 * MiB, WS_KB = 1014 * MiB, WS_VB = 1080 * MiB;
constexpr size_t WS_VT = 1146 * MiB;
constexpr size_t WS_OB = 1210 * MiB;
constexpr size_t WS_CL = 1276 * MiB;
constexpr size_t WS_END = 1278 * MiB;
constexpr int CW_TMO = 0, CW_BAR = 4096, CW_KMAX = 8192;
constexpr float SKIP_THR = 40.0f;

namespace pg8 {
constexpr int BM = 256, BK = 64, HALF = 128, HTB = HALF * BK * 2, STAGE_BYTES = 8 * HTB, NXCD = 8, WGM = 8;
__host__ __device__ __forceinline__ int lds_byte(int r, int c) { const int st = (r >> 4) * 2 + (c >> 5), rr = r & 15, cc = c & 31, ob = rr * 64 + cc * 2; return st * 1024 + (ob ^ (((ob >> 9) & 1) << 5)); }
__host__ __device__ __forceinline__ void stage_rc(int b, int& R, int& C) { const int st = b / 1024, sb = b % 1024, swz = sb ^ (((sb >> 9) & 1) << 5); R = (st >> 1) * 16 + swz / 64; C = (st & 1) * 32 + (swz % 64) / 2; }
__host__ __device__ __forceinline__ int perm32(int rho) { const int n = rho >> 4, i = rho & 15; return 8 * (i >> 2) + 4 * n + (i & 3); }

struct Unit { int pm, pn; };
struct Gemm { const bf16* A; const bf16* Bt; int lda, ldb, K; };

struct StaticOrder {
    int nM, nN, nwg, G, c, gdiv; unsigned gkb;
    __device__ void init(int M_, int N_, int G_, int c_, int gdiv_ = 0, unsigned gkb_ = 0) { nM = M_ / BM; nN = N_ / BM; nwg = nM * nN; G = G_; c = c_; gdiv = gdiv_; gkb = gkb_; }
    __device__ bool next(int i, Unit& u) const {
        const long L = (long)i * G + c; if (L >= nwg) return false;
        int wgid = (int)L; { const int q = nwg / NXCD, r = nwg % NXCD, xcd = wgid % NXCD, off = wgid / NXCD; wgid = (xcd < r ? xcd * (q + 1) : r * (q + 1) + (xcd - r) * q) + off; }
        const int nig = WGM * nN, gid = wgid / nig, fm = gid * WGM, gsz = (nM - fm) < WGM ? (nM - fm) : WGM;
        u.pm = fm + ((wgid % nig) % gsz); u.pn = (wgid % nig) / gsz; return true;
    }
    __device__ __forceinline__ size_t a_off(const Unit& u) const { return gdiv ? (size_t)(u.pn / gdiv) * gkb : (size_t)0; }
};

__device__ __forceinline__ unsigned cvt_pk_bf16(float lo, float hi) { unsigned r; asm volatile("v_cvt_pk_bf16_f32 %0, %1, %2" : "=v"(r) : "v"(lo), "v"(hi)); return r; }


struct EpiSwiglu {
    static constexpr bool PERM = true;
    bf16* Hout;
    __device__ __forceinline__ void operator()(const f32x4 (&acc)[2][2][4][2], const Unit& u, int wr, int wc, int fr, int fq) const {
        const int row0 = u.pm * BM + wr * 64 + fr, col0 = u.pn * HALF + wc * 32 + 8 * fq;
#pragma unroll
        for (int ai = 0; ai < 2; ++ai)
#pragma unroll
            for (int m = 0; m < 4; ++m) {
                bf16* rowp = Hout + (size_t)(row0 + ai * HALF + m * 16) * FF + col0;
                float hv[8];
#pragma unroll
                for (int n = 0; n < 2; ++n)
#pragma unroll
                    for (int j = 0; j < 4; ++j) { const float a = acc[ai][0][m][n][j], b = acc[ai][1][m][n][j];
                        const float sg = __builtin_amdgcn_rcpf(1.0f + __builtin_amdgcn_exp2f(-a * LOG2E)); hv[n * 4 + j] = a * sg * b; }
                u32x4 w; w.x = cvt_pk_bf16(hv[0], hv[1]); w.y = cvt_pk_bf16(hv[2], hv[3]); w.z = cvt_pk_bf16(hv[4], hv[5]); w.w = cvt_pk_bf16(hv[6], hv[7]);
                *(u32x4*)rowp = w; }
    }
};
struct EpiResid {
    static constexpr bool PERM = false;
    float* S; const float* srcP; const float* srcS; float r; const float* cs;
    __device__ __forceinline__ void operator()(const f32x4 (&acc)[2][2][4][2], const Unit& u, int wr, int wc, int fr, int fq) const {
        const int col0 = u.pn * BM + wc * 32 + 4 * fq; const int rowb = u.pm * BM + wr * 64 + fr;
        const float* src = (rowb < SEQ) ? srcP : (srcS - (size_t)SEQ * D);
        f32x4 sc[2][2];
#pragma unroll
        for (int bj = 0; bj < 2; ++bj)
#pragma unroll
            for (int n = 0; n < 2; ++n) { sc[bj][n] = cs ? *(const f32x4*)(cs + col0 + bj * HALF + n * 16) : (f32x4){1.f, 1.f, 1.f, 1.f}; sc[bj][n] = sc[bj][n] * r; }
#pragma unroll
        for (int ai = 0; ai < 2; ++ai)
#pragma unroll
            for (int m = 0; m < 4; ++m) { const size_t off = (size_t)(rowb + ai * HALF + m * 16) * D + col0;
#pragma unroll
                for (int bj = 0; bj < 2; ++bj)
#pragma unroll
                    for (int n = 0; n < 2; ++n) { const f32x4 x = *(const f32x4*)(src + off + bj * HALF + n * 16);
                        *(f32x4*)(S + off + bj * HALF + n * 16) = x * ALPHA + acc[ai][bj][m][n] * sc[bj][n]; }
                asm volatile("" ::: "memory"); }
    }
};
struct EpiQKV {
    static constexpr bool PERM = true;
    bf16* Q; size_t bstride; float *kP, *kS;
    __device__ __forceinline__ void operator()(const f32x4 (&acc)[2][2][4][2], const Unit& u, int wr, int wc, int fr, int fq) const {
        const int t = u.pn >> 3, colt = (u.pn & 7) * BM; const int rowb = u.pm * BM + wr * 64 + fr, col0 = colt + wc * 32 + 8 * fq;
        bf16* ob = Q + (size_t)t * bstride;
        const size_t tv = (t == 2) ? 1 : 0;
        float* of = (rowb < SEQ) ? (kP + tv * (O_VP - O_KP)) : (kS + tv * (O_VS - O_KS) - (size_t)SEQ * D);
        const float sc = (t == 0) ? QSCALE : 1.0f;
#pragma unroll
        for (int ai = 0; ai < 2; ++ai)
#pragma unroll
            for (int m = 0; m < 4; ++m) { const size_t off = (size_t)(rowb + ai * HALF + m * 16) * D + col0;
#pragma unroll
                for (int bj = 0; bj < 2; ++bj) { const f32x4 v0 = acc[ai][bj][m][0], v1 = acc[ai][bj][m][1];
                    u32x4 w; w.x = cvt_pk_bf16(v0[0] * sc, v0[1] * sc); w.y = cvt_pk_bf16(v0[2] * sc, v0[3] * sc); w.z = cvt_pk_bf16(v1[0] * sc, v1[1] * sc); w.w = cvt_pk_bf16(v1[2] * sc, v1[3] * sc);
                    *(u32x4*)(ob + off + bj * HALF) = w;
                    if (t != 0) { *(f32x4*)(of + off + bj * HALF) = v0; *(f32x4*)(of + off + bj * HALF + 4) = v1; } } }
    }
};

template <class Epi, class Sched, bool ALIGN_EPI = true>
__device__ __forceinline__ void gemm_phase(LAS unsigned char* lds, const Gemm g, const Sched& S, const Epi& E, const int tid) {
    const int wid = __builtin_amdgcn_readfirstlane(tid >> 6), lane = tid & 63, wr = wid >> 2, wc = wid & 3, fr = lane & 15, fq = lane >> 4;
    const int K = g.K, nt = K / BK;
    unsigned voffA[2], voffB[2];
#pragma unroll
    for (int i = 0; i < 2; ++i) { int R, C; stage_rc(tid * 16 + i * 8192, R, C); const int Rb = Epi::PERM ? ((R & ~31) + perm32(R & 31)) : R;
        voffA[i] = (unsigned)(R * g.lda + C) * 2u; voffB[i] = (unsigned)(Rb * g.ldb + C) * 2u; }
    const size_t kstep = (size_t)(BK * 2);
    const size_t hstepA = (size_t)HALF * g.lda * 2, hstepB = (size_t)HALF * g.ldb * 2;
    const size_t tstepA = 2 * hstepA, tstepB = 2 * hstepB;
    const unsigned ldsw = (unsigned)wid * 1024u;
    const int aoff = lds_byte(wr * 64 + fr, fq * 8), boff = lds_byte(wc * 32 + fr, fq * 8);
#define PG8_SA(b, h) (((b) * 2 + (h)) * HTB)
#define PG8_SB(b, h) ((4 + (b) * 2 + (h)) * HTB)
#define PG8_STAGE(bufoff, gbase, voff) do { _Pragma("unroll") for (int _i = 0; _i < 2; ++_i) \
        __builtin_amdgcn_global_load_lds((const unsigned*)((const char*)(gbase) + (voff)[_i]), (LAS unsigned*)(lds + (bufoff) + ldsw + _i * 8192), 16, 0, 0); } while (0)
#define PG8_LDA(dst, b, h) do { _Pragma("unroll") for (int m = 0; m < 4; ++m) _Pragma("unroll") for (int k = 0; k < 2; ++k) dst[m][k] = *(const LAS bf16x8*)(lds + PG8_SA(b, h) + aoff + m * 2048 + k * 1024); } while (0)
#define PG8_LDB(dst, b, h) do { _Pragma("unroll") for (int n = 0; n < 2; ++n) _Pragma("unroll") for (int k = 0; k < 2; ++k) dst[n][k] = *(const LAS bf16x8*)(lds + PG8_SB(b, h) + boff + n * 2048 + k * 1024); } while (0)
#define PG8_MMA(ai, bj, At, Bt) do { __builtin_amdgcn_s_setprio(1); _Pragma("unroll") for (int m = 0; m < 4; ++m) _Pragma("unroll") for (int n = 0; n < 2; ++n) _Pragma("unroll") for (int k = 0; k < 2; ++k) \
        acc[ai][bj][m][n] = __builtin_amdgcn_mfma_f32_16x16x32_bf16(Bt[n][k], At[m][k], acc[ai][bj][m][n], 0, 0, 0); __builtin_amdgcn_s_setprio(0); } while (0)
#define PG8_WAIT_V(n) asm volatile("s_waitcnt vmcnt(" #n ")" ::: "memory")
#define PG8_WAIT_L(n) asm volatile("s_waitcnt lgkmcnt(" #n ")" ::: "memory")
#define PG8_BAR __builtin_amdgcn_s_barrier()
#define PG8_SCHED __builtin_amdgcn_sched_barrier(0)
    Unit cur, nxt; int ui = 0;
    if (!S.next(0, cur)) return;
    f32x4 acc[2][2][4][2];
#pragma unroll
    for (int a = 0; a < 2; ++a)
#pragma unroll
        for (int b = 0; b < 2; ++b)
#pragma unroll
            for (int m = 0; m < 4; ++m)
#pragma unroll
                for (int n = 0; n < 2; ++n) acc[a][b][m][n] = (f32x4){0.f, 0.f, 0.f, 0.f};
    bf16x8 At[4][2], B0[2][2], B1[2][2];
    const char* cA = (const char*)g.A + (size_t)cur.pm * tstepA + S.a_off(cur); const char* cB = (const char*)g.Bt + (size_t)cur.pn * tstepB;
    PG8_STAGE(PG8_SB(0, 0), cB, voffB); PG8_STAGE(PG8_SB(0, 1), cB + hstepB, voffB); PG8_STAGE(PG8_SA(0, 0), cA, voffA); PG8_STAGE(PG8_SA(0, 1), cA + hstepA, voffA);
    if (wr == 1) PG8_BAR;
    PG8_WAIT_V(2); PG8_BAR;
    PG8_STAGE(PG8_SB(1, 0), cB + kstep, voffB); PG8_STAGE(PG8_SA(1, 0), cA + kstep, voffA); PG8_STAGE(PG8_SB(1, 1), cB + hstepB + kstep, voffB);
    PG8_WAIT_V(6); PG8_BAR;
    for (;;) {
        const bool has_next = S.next(ui + 1, nxt);
        const char* nA = has_next ? (const char*)g.A + (size_t)nxt.pm * tstepA + S.a_off(nxt) : cA; const char* nB = has_next ? (const char*)g.Bt + (size_t)nxt.pn * tstepB : cB;
        for (int t = 0; t < nt; t += 2) {
            const bool last = (t == nt - 2);
            const char* a1 = cA + (size_t)(t + 1) * kstep;
            const char* a2 = last ? nA : cA + (size_t)(t + 2) * kstep; const char* b2 = last ? nB : cB + (size_t)(t + 2) * kstep;
            const char* a3 = a2 + kstep; const char* b3 = b2 + kstep;
            PG8_LDB(B0, 0, 0); PG8_LDB(B1, 0, 1); PG8_SCHED; PG8_LDA(At, 0, 0); PG8_STAGE(PG8_SA(1, 1), a1 + hstepA, voffA);
            PG8_WAIT_V(8); PG8_WAIT_L(0); PG8_BAR; PG8_MMA(0, 0, At, B0); PG8_MMA(0, 1, At, B1); PG8_BAR; PG8_SCHED;
            PG8_LDA(At, 0, 1); PG8_STAGE(PG8_SB(0, 0), b2, voffB); PG8_STAGE(PG8_SB(0, 1), b2 + hstepB, voffB); PG8_STAGE(PG8_SA(0, 0), a2, voffA);
            PG8_WAIT_V(8); PG8_WAIT_L(0); PG8_BAR; PG8_MMA(1, 0, At, B0); PG8_MMA(1, 1, At, B1); PG8_BAR; PG8_SCHED;
            PG8_LDB(B0, 1, 0); PG8_LDB(B1, 1, 1); PG8_SCHED; PG8_LDA(At, 1, 0); PG8_STAGE(PG8_SA(0, 1), a2 + hstepA, voffA);
            PG8_WAIT_V(8); PG8_WAIT_L(0); PG8_BAR; PG8_MMA(0, 0, At, B0); PG8_MMA(0, 1, At, B1); PG8_BAR; PG8_SCHED;
            PG8_LDA(At, 1, 1); PG8_STAGE(PG8_SB(1, 0), b3, voffB); PG8_STAGE(PG8_SB(1, 1), b3 + hstepB, voffB); PG8_STAGE(PG8_SA(1, 0), a3, voffA);
            PG8_WAIT_V(8); PG8_WAIT_L(0); PG8_BAR; PG8_MMA(1, 0, At, B0); PG8_MMA(1, 1, At, B1); PG8_BAR; PG8_SCHED;
        }
        if constexpr (ALIGN_EPI) { if (wr == 0) PG8_BAR; }
        E(acc, cur, wr, wc, fr, fq);
        if (!has_next) break;
#pragma unroll
        for (int a = 0; a < 2; ++a)
#pragma unroll
            for (int b = 0; b < 2; ++b)
#pragma unroll
                for (int m = 0; m < 4; ++m)
#pragma unroll
                    for (int n = 0; n < 2; ++n) acc[a][b][m][n] = (f32x4){0.f, 0.f, 0.f, 0.f};
        cur = nxt; cA = nA; cB = nB; ++ui;
        if constexpr (ALIGN_EPI) { if (wr == 1) PG8_BAR; }
    }
    PG8_WAIT_V(0);
    if constexpr (!ALIGN_EPI) { if (wr == 0) PG8_BAR; }
    PG8_BAR;
#undef PG8_SA
#undef PG8_SB
#undef PG8_STAGE
#undef PG8_LDA
#undef PG8_LDB
#undef PG8_MMA
#undef PG8_WAIT_V
#undef PG8_WAIT_L
#undef PG8_BAR
#undef PG8_SCHED
}
}

constexpr int NWAVES = 8;
constexpr int RING_OFF = 0, RING_BYTES = 131072;
constexpr int LDSCTL_OFF = RING_BYTES, MISC_OFF = LDSCTL_OFF + 320;
constexpr int LDS_BYTES = 147456;

typedef GAS unsigned gu32;
#define RLX_AGENT __ATOMIC_RELAXED, __HIP_MEMORY_SCOPE_AGENT
#define LDS_WAIT() asm volatile("s_waitcnt lgkmcnt(0)" ::: "memory")
#define VM_WAIT() asm volatile("s_waitcnt vmcnt(0)" ::: "memory")
__device__ __forceinline__ unsigned f2bf(float f) { unsigned u = __builtin_bit_cast(unsigned, f); return (u + 0x7fffu + ((u >> 16) & 1u)) >> 16; }
__device__ __forceinline__ unsigned pk2(float lo, float hi) { return f2bf(lo) | (f2bf(hi) << 16); }
__device__ __forceinline__ unsigned cvtpk(float lo, float hi) { f32x2 v = {lo, hi}; bf16x2_t b = __builtin_convertvector(v, bf16x2_t); return __builtin_bit_cast(unsigned, b); }
__device__ __forceinline__ float bf_lo(unsigned w) { return __builtin_bit_cast(float, w << 16); }
__device__ __forceinline__ float bf_hi(unsigned w) { return __builtin_bit_cast(float, w & 0xffff0000u); }

#define XB_TMO      128
#define XB_XCNT(j)  (256  + 64 * (j))
#define XB_XSUB(j)  (1280 + 64 * (j))
#define XB_XGEN(j)  (2304 + 64 * (j))
#define XB_TOP      3328
#define XB_TOPGEN   3392
#define XCD_BAR_WORDS 3456
#define XB_SPIN_CAP (1u << 18)
__device__ __forceinline__ unsigned xb_ld(unsigned* p)              { return __hip_atomic_load(p, __ATOMIC_RELAXED, __HIP_MEMORY_SCOPE_AGENT); }
__device__ __forceinline__ unsigned xb_add(unsigned* p, unsigned v) { return __hip_atomic_fetch_add(p, v, __ATOMIC_RELAXED, __HIP_MEMORY_SCOPE_AGENT); }
__device__ __forceinline__ unsigned xb_xcc_id() { return (unsigned)__builtin_amdgcn_s_getreg((3 << 11) | 20) & 0xFu; }
#define XB_SPIN(cond, bar) do { unsigned _sp = 0; while (cond) { __builtin_amdgcn_s_sleep(1); \
    if ((++_sp & 255u) == 0u) { if (xb_ld(&(bar)[XB_TMO])) break; if (_sp > XB_SPIN_CAP) { atomicAdd(&(bar)[XB_TMO], 1u); break; } } } } while (0)
struct XcdBarrier { unsigned* bar; unsigned x; volatile LAS unsigned* st; };
__device__ __forceinline__ XcdBarrier xcd_barrier_post(unsigned* bar, volatile LAS unsigned* st, const int tid) {
    XcdBarrier b; b.bar = bar; b.x = xb_xcc_id(); b.st = st;
    if (tid == 0) (void)xb_add(&bar[XB_XCNT(b.x)], 1u);
    return b;
}
__device__ __forceinline__ void xcd_barrier_complete(unsigned* bar, unsigned x, unsigned& nloc, unsigned& nx) {
    const unsigned G = gridDim.x * gridDim.y * gridDim.z;
    unsigned sum, cnt, mine, sp = 0u;
    for (;;) {
        sum = 0u; cnt = 0u; mine = 0u;
#pragma unroll
        for (unsigned j = 0; j < 16; ++j) { const unsigned c = xb_ld(&bar[XB_XCNT(j)]); sum += c; cnt += (c > 0u) ? 1u : 0u; mine = (j == x) ? c : mine; }
        if (sum == G) break;
        __builtin_amdgcn_s_sleep(1);
        if ((++sp & 255u) == 0u) { if (xb_ld(&bar[XB_TMO])) break; if (sp > XB_SPIN_CAP) { atomicAdd(&bar[XB_TMO], 1u); break; } }
    }
    nloc = mine > 0u ? mine : 1u; nx = cnt > 0u ? cnt : 1u;
}
__device__ __forceinline__ void xcd_barrier(const XcdBarrier& b, const int tid) {
    asm volatile("s_waitcnt vmcnt(0)" ::: "memory");
    __syncthreads();
    if (tid == 0) {
        unsigned* bar = b.bar;
        __builtin_amdgcn_s_waitcnt(0);
        unsigned nloc = b.st[0], nx = b.st[1];
        if (nloc == 0u) { xcd_barrier_complete(bar, b.x, nloc, nx); b.st[0] = nloc; b.st[1] = nx; }
        const unsigned old = xb_add(&bar[XB_XSUB(b.x)], 1u);
        const unsigned gen = old / nloc;
        if (old + 1u == (gen + 1u) * nloc) {
            __builtin_amdgcn_fence(__ATOMIC_RELEASE, "agent");
            asm volatile("s_waitcnt vmcnt(0)" ::: "memory");
            const unsigned og = xb_add(&bar[XB_TOP], 1u);
            const unsigned tg = og / nx;
            if (og + 1u == (tg + 1u) * nx) xb_add(&bar[XB_TOPGEN], 1u);
            else XB_SPIN(xb_ld(&bar[XB_TOPGEN]) == tg, bar);
            __builtin_amdgcn_fence(__ATOMIC_ACQUIRE, "agent");
            xb_add(&bar[XB_XGEN(b.x)], 1u);
            asm volatile("s_waitcnt vmcnt(0)" ::: "memory");
        } else {
            XB_SPIN(xb_ld(&bar[XB_XGEN(b.x)]) == gen, bar);
            __builtin_amdgcn_fence(__ATOMIC_ACQUIRE, "agent");
            asm volatile("s_waitcnt vmcnt(0)" ::: "memory");
        }
    }
    __syncthreads();
}

struct Frame {
    LAS unsigned char* lds;
    int tid, lane, wave, vcu, G;
    const float *xP, *xS, *spool, *cK, *cV, *cLF, *lng, *lnb, *w1, *w3, *w2, *poolw, *pools, *win, *bfg, *wo;
    float* out;
    bf16 *W13, *W2T, *WIN, *WO, *POOLT, *XBF, *HB, *DB, *QB, *KB, *VB, *VT, *OB;
    float *S, *CL; unsigned* ctl;
};

__device__ __forceinline__ float wave_sum(float v) {
#pragma unroll
    for (int o = 1; o < 64; o <<= 1) v += __shfl_xor(v, o);
    return v;
}

__device__ __forceinline__ void p0_transpose_item(const float* W, int ldw, int Kd, bf16* WT, int k0, int n0, int drow0, LAS float* scr, int lane) {
#pragma unroll 8
    for (int i = 0; i < 32; ++i) { const int kk = 2 * i + (lane >> 5); scr[kk * 33 + (lane & 31)] = W[(size_t)(k0 + kk) * ldw + n0 + (lane & 31)]; }
    LDS_WAIT(); asm volatile("" ::: "memory");
    const int c = lane & 7;
#pragma unroll
    for (int j = 0; j < 4; ++j) { const int n = (lane >> 3) + 8 * j; const LAS float* s = scr + (8 * c) * 33 + n;
        v4u o; o.x = pk2(s[0 * 33], s[1 * 33]); o.y = pk2(s[2 * 33], s[3 * 33]); o.z = pk2(s[4 * 33], s[5 * 33]); o.w = pk2(s[6 * 33], s[7 * 33]);
        *(GAS v4u*)(WT + (size_t)(drow0 + n) * Kd + k0 + 8 * c) = o; }
    LDS_WAIT(); asm volatile("" ::: "memory");
}
__device__ __forceinline__ void p0_prologue(Frame& F) {
    LAS float* scr = (LAS float*)(F.lds + RING_OFF + F.wave * 16384);
    const int gw = F.vcu * NWAVES + F.wave, NGW = F.G * NWAVES;
    constexpr int I_UP = (D / 64) * (FF / 32);
    constexpr int I_DN = (FF / 64) * (D / 32);
    constexpr int I_IN = (D / 64) * (3 * D / 32);
    constexpr int I_WO = (D / 64) * (D / 32);
    constexpr int I_PL = 4 * (512 / 64) * (512 / 32);
    constexpr int NITEMS = 12 * 8192 + I_IN + I_WO + I_PL;
    static_assert(I_UP == 8192 && I_DN == 8192, "items");
    for (int it = gw; it < NITEMS; it += NGW) {
        int r = it;
        if (r < 8 * 8192) {
            const int mat = r >> 13, f = mat >> 1, which = mat & 1, q = r & 8191; const int nblk = FF / 32, kb = q / nblk, nb = q % nblk, n0 = 32 * nb;
            const float* W = (which ? F.w3 : F.w1) + (size_t)f * D * FF;
            p0_transpose_item(W, FF, D, F.W13 + (size_t)f * 2 * FF * D, 64 * kb, n0, 256 * (n0 >> 7) + (n0 & 127) + 128 * which, scr, F.lane); continue; }
        r -= 8 * 8192;
        if (r < 4 * 8192) { const int f = r >> 13, q = r & 8191; const int nblk = D / 32, kb = q / nblk, nb = q % nblk;
            p0_transpose_item(F.w2 + (size_t)f * FF * D, D, FF, F.W2T + (size_t)f * D * FF, 64 * kb, 32 * nb, 32 * nb, scr, F.lane); continue; }
        r -= 4 * 8192;
        if (r < I_IN) { const int nblk = 3 * D / 32, kb = r / nblk, nb = r % nblk;
            p0_transpose_item(F.win, WIN_LD, D, F.WIN, 64 * kb, 32 * nb, 32 * nb, scr, F.lane); continue; }
        r -= I_IN;
        if (r < I_WO) { const int nblk = D / 32, kb = r / nblk, nb = r % nblk;
            p0_transpose_item(F.wo, D, D, F.WO, 64 * kb, 32 * nb, 32 * nb, scr, F.lane); continue; }
        r -= I_WO;
        { const int g = r >> 7, q = r & 127, kb = q >> 4, nb = q & 15;
            p0_transpose_item(F.poolw + (size_t)g * 512 * 512, 512, 512, F.POOLT, 64 * kb, 32 * nb, g * 512 + 32 * nb, scr, F.lane); }
    }
    for (int m = gw; m < M; m += NGW) {
        const float* xrow = (m < SEQ) ? F.xP + (size_t)m * D : F.xS + (size_t)(m - SEQ) * D;
        const GAS f32x4* xr = (const GAS f32x4*)xrow + F.lane;
        GAS u32x2* o8 = (GAS u32x2*)(F.XBF + (size_t)m * D) + F.lane;
#pragma unroll
        for (int j = 0; j < 8; ++j) { const f32x4 v = xr[64 * j]; u32x2 w; w.x = pk2(v.x, v.y); w.y = pk2(v.z, v.w); o8[64 * j] = w; }
    }
}

template <bool WBF, bool WPOOL, bool LOGF, bool FINAL>
__device__ __forceinline__ void ln_pass(Frame& F, const float* g, const float* b) {
    const int gw = F.vcu * NWAVES + F.wave, NGW = F.G * NWAVES, lane = F.lane;
    LAS float* wft = (LAS float*)(F.lds + RING_OFF);
    if (LOGF) {
        for (int idx = F.tid; idx < D * NH; idx += NWAVES * 64) { const int c = idx >> 4, h = idx & 15; wft[h * D + c] = F.win[(size_t)c * WIN_LD + 3 * D + h]; }
        __syncthreads();
    }
    f32x4 gv[8], bv[8];
#pragma unroll
    for (int j = 0; j < 8; ++j) { gv[j] = ((const GAS f32x4*)g)[lane + 64 * j]; bv[j] = ((const GAS f32x4*)b)[lane + 64 * j]; }
    for (int row = gw; row < M; row += NGW) {
        float* srow = F.S + (size_t)row * D;
        f32x4 v[8]; float s = 0.f;
#pragma unroll
        for (int j = 0; j < 8; ++j) { v[j] = ((const GAS f32x4*)srow)[lane + 64 * j]; s += (v[j].x + v[j].y) + (v[j].z + v[j].w); }
        const float mean = wave_sum(s) * (1.f / D); float s2 = 0.f;
#pragma unroll
        for (int j = 0; j < 8; ++j) { v[j] = v[j] - mean; s2 += (v[j].x * v[j].x + v[j].y * v[j].y) + (v[j].z * v[j].z + v[j].w * v[j].w); }
        const float rstd = 1.f / sqrtf(wave_sum(s2) * (1.f / D) + LN_EPS);
#pragma unroll
        for (int j = 0; j < 8; ++j) v[j] = v[j] * rstd * gv[j] + bv[j];
        if (FINAL) {
            float* orow = (row < SEQ) ? F.out + O_YP + (size_t)row * D : F.out + O_YS + (size_t)(row - SEQ) * D;
#pragma unroll
            for (int j = 0; j < 8; ++j) ((GAS f32x4*)orow)[lane + 64 * j] = v[j];
        } else {
#pragma unroll
            for (int j = 0; j < 8; ++j) ((GAS f32x4*)srow)[lane + 64 * j] = v[j];
        }
        if (WBF) {
            GAS u32x2* o8 = (GAS u32x2*)(F.XBF + (size_t)row * D) + lane;
#pragma unroll
            for (int j = 0; j < 8; ++j) { u32x2 w; w.x = pk2(v[j].x, v[j].y); w.y = pk2(v[j].z, v[j].w); o8[64 * j] = w; }
        }
        if (WPOOL) {
            float* prow = nullptr;
            if (row >= SEQ - PST && row < SEQ) prow = F.out + O_PP + (size_t)(row - (SEQ - PST)) * D;
            else if (row >= SEQ) { const int bb = (row - SEQ) >> 4, i = (row - SEQ) & 15; if (i >= 1) prow = F.out + O_PS + ((size_t)bb * PST + (i - 1)) * D; }
            if (prow) {
#pragma unroll
                for (int j = 0; j < 8; ++j) ((GAS f32x4*)prow)[lane + 64 * j] = v[j];
            }
        }
        if (LOGF) {
            float mine = 0.f;
#pragma unroll 1
            for (int h = 0; h < NH; ++h) {
                float p = 0.f;
#pragma unroll
                for (int j = 0; j < 8; ++j) { const f32x4 w = *(const LAS f32x4*)(wft + h * D + 4 * lane + 256 * j); p += (v[j].x * w.x + v[j].y * w.y) + (v[j].z * w.z + v[j].w * w.w); }
                p = wave_sum(p);
                mine = (lane == h) ? p : mine;
            }
            if (lane < NH) {
                const float z = mine + F.bfg[lane];
                const float lf = (z >= 0.f) ? -log1pf(expf(-z)) : (z - log1pf(expf(z)));
                float* lp = (row < SEQ) ? F.out + O_LP + (size_t)row * NH : F.out + O_LS + (size_t)(row - SEQ) * NH;
                lp[lane] = lf;
            }
        }
    }
    if (LOGF) __syncthreads();
}

__device__ __forceinline__ f32x4 pool_fetch(Frame& F, int kind, int b, int idx, int c4) {
    if (kind == 0) { if (idx < 0) return (f32x4){0.f, 0.f, 0.f, 0.f}; return *(const GAS f32x4*)(F.S + (size_t)idx * D + c4); }
    if (idx < PST) return *(const GAS f32x4*)(F.spool + ((size_t)b * PST + idx) * D + c4);
    return *(const GAS f32x4*)(F.S + (size_t)(SEQ + b * DECT + idx - PST) * D + c4);
}
__device__ __forceinline__ void pool_pass(Frame& F) {
    const int c4 = 4 * F.tid, grp = F.tid >> 7, w = 2 << grp;
    constexpr int NRUN_P = SEQ / 8, NRUN = NRUN_P + DECB * 2;
    for (int run = F.vcu; run < NRUN; run += F.G) {
        int kind, b, i0, orow0;
        if (run < NRUN_P) { kind = 0; b = 0; i0 = run * 8; orow0 = i0; }
        else { const int r = run - NRUN_P; kind = 1; b = r >> 1; i0 = PST + (r & 1) * 8; orow0 = SEQ + b * DECT + (r & 1) * 8; }
        f32x4 acc = (f32x4){0.f, 0.f, 0.f, 0.f};
        for (int j = 1; j < w; ++j) acc = acc + pool_fetch(F, kind, b, i0 - j, c4);
#pragma unroll
        for (int e = 0; e < 8; ++e) {
            const int i = i0 + e;
            const f32x4 x = pool_fetch(F, kind, b, i, c4);
            acc = acc + x;
            const int cnti = (kind == 0) ? ((i + 1 < w) ? i + 1 : w) : w;
            const float cnt = (float)cnti;
            const f32x4 d = acc / cnt - x;
            u32x2 o; o.x = pk2(d.x, d.y); o.y = pk2(d.z, d.w);
            *(GAS u32x2*)(F.DB + (size_t)(orow0 + e) * D + c4) = o;
            acc = acc - pool_fetch(F, kind, b, i - w + 1, c4);
        }
    }
}

__device__ __forceinline__ float block_excl_scan(float v, LAS float* buf, int tid) {
    buf[tid] = v; __syncthreads();
    int src = 0;
    for (int off = 1; off < 512; off <<= 1) {
        float x = buf[src * 512 + tid]; if (tid >= off) x += buf[src * 512 + tid - off];
        buf[(src ^ 1) * 512 + tid] = x; __syncthreads(); src ^= 1;
    }
    const float incl = buf[src * 512 + tid]; __syncthreads();
    return incl - v;
}

__device__ __forceinline__ void scan_vt_pass(Frame& F) {
    if (F.vcu < NH) {
        const int h = F.vcu; const float* lf = F.out + O_LP;
        LAS float* buf = (LAS float*)(F.lds + RING_OFF);
        const int t0 = 32 * F.tid; float tot = 0.f;
#pragma unroll 8
        for (int e = 0; e < 32; ++e) tot += lf[(size_t)(t0 + e) * NH + h];
        float run = block_excl_scan(tot, buf, F.tid);
#pragma unroll 8
        for (int e = 0; e < 32; ++e) { run += lf[(size_t)(t0 + e) * NH + h]; F.CL[(size_t)h * SEQ + t0 + e] = run * LOG2E; }
        __syncthreads();
    }
    {
        const int gw = F.vcu * NWAVES + F.wave, NGW = F.G * NWAVES;
        float rmax[4] = {0.f, 0.f, 0.f, 0.f};
        for (int row = gw; row < SEQ; row += NGW) {
            const GAS u32x4* kp = (const GAS u32x4*)(F.KB + (size_t)row * D) + F.lane;
#pragma unroll
            for (int j = 0; j < 4; ++j) { const u32x4 v = kp[64 * j]; float s = 0.f;
                s += bf_lo(v.x) * bf_lo(v.x) + bf_hi(v.x) * bf_hi(v.x); s += bf_lo(v.y) * bf_lo(v.y) + bf_hi(v.y) * bf_hi(v.y);
                s += bf_lo(v.z) * bf_lo(v.z) + bf_hi(v.z) * bf_hi(v.z); s += bf_lo(v.w) * bf_lo(v.w) + bf_hi(v.w) * bf_hi(v.w);
                s += __shfl_xor(s, 1); s += __shfl_xor(s, 2); s += __shfl_xor(s, 4); s += __shfl_xor(s, 8);
                rmax[j] = fmaxf(rmax[j], s); }
        }
        if ((F.lane & 15) == 0) {
#pragma unroll
            for (int j = 0; j < 4; ++j) atomicMax(F.ctl + CW_KMAX + (F.lane >> 4) + 4 * j, __float_as_uint(rmax[j]));
        }
    }
    LAS unsigned* T = (LAS unsigned*)(F.lds + RING_OFF);
    constexpr int NIT = NH * (SEQ / 64);
    for (int it = F.vcu; it < NIT; it += F.G) {
        const int h = it & 15, sb = it >> 4, s0 = sb * 64;
#pragma unroll
        for (int i = 0; i < 2; ++i) { const int cidx = F.tid + 512 * i, s = cidx >> 4, dc = cidx & 15;
            const u32x4 v = *(const GAS u32x4*)(F.VB + (size_t)(s0 + s) * D + h * DH + 8 * dc);
            LAS unsigned* p = T + s * 65 + 4 * dc; p[0] = v.x; p[1] = v.y; p[2] = v.z; p[3] = v.w; }
        __syncthreads();
#pragma unroll
        for (int i = 0; i < 2; ++i) { const int cidx = F.tid + 512 * i, d = cidx >> 3, sc = cidx & 7;
            const LAS unsigned short* ps = (const LAS unsigned short*)T + d;
            unsigned e[8];
#pragma unroll
            for (int j = 0; j < 8; ++j) e[j] = ps[(size_t)(8 * sc + j) * 130];
            u32x4 o; o.x = e[0] | (e[1] << 16); o.y = e[2] | (e[3] << 16); o.z = e[4] | (e[5] << 16); o.w = e[6] | (e[7] << 16);
            *(GAS u32x4*)(F.VT + ((size_t)h * DH + d) * SEQ + s0 + 8 * sc) = o; }
        __syncthreads();
    }
}

#define MFMA32(a, b, c) __builtin_amdgcn_mfma_f32_32x32x16_bf16((a), (b), (c), 0, 0, 0)
__device__ __forceinline__ int kswz(int row, int colB) { return row * 256 + (colB ^ ((row & 7) << 4)); }
constexpr int AT_K = 0, AT_V = 32768, AT_C = 65536;

__device__ __forceinline__ void attn_prompt_unit(Frame& F, int h, int qb) {
    LAS unsigned char* lds = F.lds + RING_OFF;
    const int tid = F.tid, w = F.wave, lane = F.lane, c = lane & 31, hh = lane >> 5;
    const int q0 = 256 * qb + 32 * w, qrow = q0 + c;
    bf16x8 qf[8];
    { const bf16* Qp = F.QB + (size_t)qrow * D + h * DH + 8 * hh;
#pragma unroll
      for (int ch = 0; ch < 8; ++ch) qf[ch] = *(const GAS bf16x8*)(Qp + 16 * ch); }
    const float cq = F.CL[(size_t)h * SEQ + qrow];
    f32x16 o[4];
#pragma unroll
    for (int db = 0; db < 4; ++db)
#pragma unroll
        for (int i = 0; i < 16; ++i) o[db][i] = 0.f;
    float m = -1e30f, lsum = 0.f;
    const int ntiles = 4 * qb + 4, tmax = 4 * qb + (w >> 1);
    float bnd;
    { float qn2 = 0.f;
#pragma unroll
      for (int ch = 0; ch < 8; ++ch) { const u32x4 qq = __builtin_bit_cast(u32x4, qf[ch]);
          qn2 += bf_lo(qq.x) * bf_lo(qq.x) + bf_hi(qq.x) * bf_hi(qq.x); qn2 += bf_lo(qq.y) * bf_lo(qq.y) + bf_hi(qq.y) * bf_hi(qq.y);
          qn2 += bf_lo(qq.z) * bf_lo(qq.z) + bf_hi(qq.z) * bf_hi(qq.z); qn2 += bf_lo(qq.w) * bf_lo(qq.w) + bf_hi(qq.w) * bf_hi(qq.w); }
      qn2 += __shfl_xor(qn2, 32);
      const float kmax2 = __uint_as_float(__hip_atomic_load(F.ctl + CW_KMAX + h, __ATOMIC_RELAXED, __HIP_MEMORY_SCOPE_AGENT));
      bnd = sqrtf(qn2 * kmax2) * 1.001f + SKIP_THR; }
    bool done = false;
    LAS unsigned* flags = (LAS unsigned*)(lds + AT_C + 512);
    const int kr0 = tid >> 4, kc = tid & 15;
    const int vd0 = tid >> 3, vc = tid & 7;
    const unsigned char* wsb = (const unsigned char*)F.S - WS_S;
    const unsigned koff = (unsigned)WS_KB + (unsigned)((kr0 * D + h * DH + 8 * kc) * 2);
    const unsigned voff = (unsigned)WS_VT + (unsigned)(((h * DH + vd0) * SEQ + 8 * vc) * 2);
    const unsigned coff = (unsigned)WS_CL + (unsigned)((h * SEQ + (tid & 63)) * 4);
    u32x4 kst[2], vst[2]; float cst = 0.f;
#define AT_LOADK(kt) do { const unsigned _k0 = 64u * (unsigned)(kt); \
        kst[0] = *(const GAS u32x4*)(wsb + (koff + _k0 * (D * 2))); kst[1] = *(const GAS u32x4*)(wsb + (koff + _k0 * (D * 2) + 32 * D * 2)); \
        if (tid < 64) cst = *(const GAS float*)(wsb + (coff + _k0 * 4)); } while (0)
#define AT_LOADV(kt) do { const unsigned _k0 = 64u * (unsigned)(kt); \
        vst[0] = *(const GAS u32x4*)(wsb + (voff + _k0 * 2)); vst[1] = *(const GAS u32x4*)(wsb + (voff + _k0 * 2 + 64 * SEQ * 2)); } while (0)
#define AT_WRITEK(buf) do { LAS unsigned char* _kb = lds + AT_K + (buf) * 16384; \
        *(LAS u32x4*)(_kb + kswz(kr0, 16 * kc)) = kst[0]; *(LAS u32x4*)(_kb + kswz(kr0 + 32, 16 * kc)) = kst[1]; \
        if (tid < 64) *(LAS float*)(lds + AT_C + (buf) * 256 + tid * 4) = cst; } while (0)
#define AT_WRITEV(buf) do { LAS unsigned char* _vb = lds + AT_V + (buf) * 16384; \
        { const int _f = (vd0 >> 1) & 15; LAS unsigned char* _r = _vb + vd0 * 128; \
          *(LAS u32x2*)(_r + (((2 * vc) ^ _f) << 3)) = (u32x2){vst[0].x, vst[0].y}; *(LAS u32x2*)(_r + (((2 * vc + 1) ^ _f) << 3)) = (u32x2){vst[0].z, vst[0].w}; } \
        { const int _d = vd0 + 64, _f = (_d >> 1) & 15; LAS unsigned char* _r = _vb + _d * 128; \
          *(LAS u32x2*)(_r + (((2 * vc) ^ _f) << 3)) = (u32x2){vst[1].x, vst[1].y}; *(LAS u32x2*)(_r + (((2 * vc + 1) ^ _f) << 3)) = (u32x2){vst[1].z, vst[1].w}; } } while (0)
    AT_LOADK(ntiles - 1); AT_LOADV(ntiles - 1); AT_WRITEK(0); AT_WRITEV(0); __syncthreads();
    int it = 0;
    for (int kt = ntiles - 1; kt >= 0; --kt, ++it) {
        const int buf = it & 1;
        const bool active = !done && kt <= tmax;
        f32x16 s0, s1;
        if (kt > 0) AT_LOADK(kt - 1);
        __builtin_amdgcn_sched_barrier(0);
        if (active) {
            const LAS unsigned char* Kb = lds + AT_K + buf * 16384;
#pragma unroll
            for (int i = 0; i < 16; ++i) { s0[i] = 0.f; s1[i] = 0.f; }
            const LAS unsigned char* Kr = Kb + c * 256;
            const int kx = (c & 7) << 4;
#pragma unroll
            for (int ch = 0; ch < 8; ++ch) {
                const int co = ((32 * (ch & 3) + 16 * hh) ^ kx) + 128 * (ch >> 2);
                const bf16x8 k0 = *(const LAS bf16x8*)(Kr + co);
                const bf16x8 k1 = *(const LAS bf16x8*)(Kr + co + 8192);
                s0 = MFMA32(k0, qf[ch], s0); s1 = MFMA32(k1, qf[ch], s1);
                __builtin_amdgcn_sched_barrier(0);
            }
        }
        __builtin_amdgcn_sched_barrier(0);
        if (kt > 0) { AT_WRITEK(buf ^ 1); AT_LOADV(kt - 1); }
        __builtin_amdgcn_sched_barrier(0);
        if (active) {
            const LAS unsigned char* Vb = lds + AT_V + buf * 16384; const LAS unsigned char* Cb = lds + AT_C + buf * 256;
#pragma unroll
            for (int g = 0; g < 4; ++g) {
                const f32x4 cb0 = *(const LAS f32x4*)(Cb + (8 * g + 4 * hh) * 4), cb1 = *(const LAS f32x4*)(Cb + (32 + 8 * g + 4 * hh) * 4);
#pragma unroll
                for (int e = 0; e < 4; ++e) { s0[4 * g + e] += cq - cb0[e]; s1[4 * g + e] += cq - cb1[e]; }
            }
            if (64 * kt + 63 > q0) {
#pragma unroll
                for (int i = 0; i < 16; ++i) { const int key = 64 * kt + (i & 3) + 8 * (i >> 2) + 4 * hh;
                    if (key > qrow) s0[i] = -INFINITY; if (key + 32 > qrow) s1[i] = -INFINITY; }
            }
            float mx = s0[0];
#pragma unroll
            for (int i = 1; i < 16; ++i) mx = fmaxf(mx, s0[i]);
#pragma unroll
            for (int i = 0; i < 16; ++i) mx = fmaxf(mx, s1[i]);
            mx = fmaxf(mx, __shfl_xor(mx, 32));
            const float mnew = fmaxf(m, mx), alpha = __builtin_amdgcn_exp2f(m - mnew); m = mnew;
            float ps = 0.f;
#pragma unroll
            for (int i = 0; i < 16; ++i) { s0[i] = __builtin_amdgcn_exp2f(s0[i] - mnew); s1[i] = __builtin_amdgcn_exp2f(s1[i] - mnew); ps += s0[i] + s1[i]; }
            lsum = lsum * alpha + ps;
            if (!__all(alpha == 1.0f)) {
#pragma unroll
                for (int db = 0; db < 4; ++db)
#pragma unroll
                    for (int i = 0; i < 16; ++i) o[db][i] *= alpha;
            }
            bf16x8 pf[2][2];
#pragma unroll
            for (int s2 = 0; s2 < 2; ++s2) {
                u32x4 a, b;
                a.x = cvtpk(s0[8 * s2 + 0], s0[8 * s2 + 1]); a.y = cvtpk(s0[8 * s2 + 2], s0[8 * s2 + 3]); a.z = cvtpk(s0[8 * s2 + 4], s0[8 * s2 + 5]); a.w = cvtpk(s0[8 * s2 + 6], s0[8 * s2 + 7]);
                b.x = cvtpk(s1[8 * s2 + 0], s1[8 * s2 + 1]); b.y = cvtpk(s1[8 * s2 + 2], s1[8 * s2 + 3]); b.z = cvtpk(s1[8 * s2 + 4], s1[8 * s2 + 5]); b.w = cvtpk(s1[8 * s2 + 6], s1[8 * s2 + 7]);
                pf[0][s2] = __builtin_bit_cast(bf16x8, a); pf[1][s2] = __builtin_bit_cast(bf16x8, b);
            }
#pragma unroll
            for (int db = 0; db < 4; ++db) {
                const int f = (c >> 1) & 15; const LAS unsigned char* rowb = Vb + c * 128 + db * 4096;
#pragma unroll
                for (int kb = 0; kb < 2; ++kb)
#pragma unroll
                    for (int s2 = 0; s2 < 2; ++s2) {
                        const int g0 = 8 * kb + 4 * s2 + hh;
                        const u32x2 lo = *(const LAS u32x2*)(rowb + ((g0 ^ f) << 3)), hi = *(const LAS u32x2*)(rowb + (((g0 + 2) ^ f) << 3));
                        const u32x4 vv = (u32x4){lo.x, lo.y, hi.x, hi.y};
                        o[db] = MFMA32(__builtin_bit_cast(bf16x8, vv), pf[kb][s2], o[db]);
                    }
                __builtin_amdgcn_sched_barrier(0);
            }
            if (kt > 0) { const float edge = *(const GAS float*)(wsb + ((unsigned)WS_CL + (unsigned)((h * SEQ + 64 * kt - 1) * 4))); done = __all(bnd + (cq - edge) < m); }
        }
        __builtin_amdgcn_sched_barrier(0);
        if (lane == 0) flags[buf * 8 + w] = done ? 1u : 0u;
        if (kt > 0) AT_WRITEV(buf ^ 1);
        __syncthreads();
        { const u32x4 f0 = *(const LAS u32x4*)(flags + buf * 8), f1 = *(const LAS u32x4*)(flags + buf * 8 + 4);
          if ((f0.x & f0.y & f0.z & f0.w & f1.x & f1.y & f1.z & f1.w) != 0u) break; }
    }
#undef AT_LOADK
#undef AT_LOADV
#undef AT_WRITEK
#undef AT_WRITEV
    const float ltot = lsum + __shfl_xor(lsum, 32), inv = 1.0f / ltot;
    bf16* Op = F.OB + (size_t)qrow * D + h * DH;
#pragma unroll
    for (int db = 0; db < 4; ++db)
#pragma unroll
        for (int g = 0; g < 4; ++g) {
            u32x2 wv; wv.x = cvtpk(o[db][4 * g] * inv, o[db][4 * g + 1] * inv); wv.y = cvtpk(o[db][4 * g + 2] * inv, o[db][4 * g + 3] * inv);
            *(GAS u32x2*)(Op + 32 * db + 8 * g + 4 * hh) = wv;
        }
}

constexpr int SA_CS = 0;
constexpr int SA_SCAN = 8448;
constexpr int SA_P = 12800;
constexpr int SA_A = 29184;
constexpr int SA_M = 29696, SA_L = 30208;
constexpr int SA_O = 32768;
__device__ __forceinline__ void attn_sample_unit(Frame& F, int b, int h) {
    LAS unsigned char* lds = F.lds + RING_OFF;
    const int tid = F.tid, w = F.wave, lane = F.lane, c = lane & 31, hh = lane >> 5, qi = c & 15;
    LAS float* cs = (LAS float*)(lds + SA_CS);
    {
        const float* lf = F.cLF + ((size_t)b * PAST) * NH + h;
        float v[4], tot = 0.f;
#pragma unroll
        for (int e = 0; e < 4; ++e) { v[e] = lf[(size_t)(4 * tid + e) * NH]; tot += v[e]; }
        float run = block_excl_scan(tot, (LAS float*)(lds + SA_SCAN), tid);
#pragma unroll
        for (int e = 0; e < 4; ++e) { run += v[e]; cs[4 * tid + e] = run * LOG2E; }
        __syncthreads();
        if (tid == 0) { float r = cs[PAST - 1]; const float* ln = F.out + O_LS + (size_t)(b * DECT) * NH + h;
            for (int i = 0; i < DECT; ++i) { r += ln[(size_t)i * NH] * LOG2E; cs[PAST + i] = r; }
            for (int i = DECT; i < 32; ++i) cs[PAST + i] = r; }
        __syncthreads();
    }
    bf16x8 qf[8];
    { const bf16* Qp = F.QB + (size_t)(SEQ + b * DECT + qi) * D + h * DH + 8 * hh;
#pragma unroll
      for (int ch = 0; ch < 8; ++ch) { bf16x8 t = *(const GAS bf16x8*)(Qp + 16 * ch); if (c >= 16) t = (bf16x8){0, 0, 0, 0, 0, 0, 0, 0}; qf[ch] = t; } }
    const float cq = cs[PAST + qi];
    float m = -1e30f, lsum = 0.f;
    float oa[16][2];
#pragma unroll
    for (int q = 0; q < 16; ++q) { oa[q][0] = 0.f; oa[q][1] = 0.f; }
    LAS float* Pw = (LAS float*)(lds + SA_P + w * 2048);
    LAS float* Aw = (LAS float*)(lds + SA_A + w * 64);
    for (int T = w; T < 65; T += NWAVES) {
        f32x16 s;
#pragma unroll
        for (int i = 0; i < 16; ++i) s[i] = 0.f;
        if (T < 64) {
            const float* kp = F.cK + (((size_t)b * PAST + 32 * T + c) * NH + h) * DH + 8 * hh;
#pragma unroll
            for (int ch = 0; ch < 8; ++ch) { const f32x4 a = *(const GAS f32x4*)(kp + 16 * ch), bb = *(const GAS f32x4*)(kp + 16 * ch + 4);
                u32x4 kk; kk.x = cvtpk(a.x, a.y); kk.y = cvtpk(a.z, a.w); kk.z = cvtpk(bb.x, bb.y); kk.w = cvtpk(bb.z, bb.w);
                s = MFMA32(__builtin_bit_cast(bf16x8, kk), qf[ch], s); }
        } else {
            const bf16* kp = F.KB + (size_t)(SEQ + b * DECT + qi) * D + h * DH + 8 * hh;
#pragma unroll
            for (int ch = 0; ch < 8; ++ch) { bf16x8 kk = *(const GAS bf16x8*)(kp + 16 * ch); if (c >= 16) kk = (bf16x8){0, 0, 0, 0, 0, 0, 0, 0};
                s = MFMA32(kk, qf[ch], s); }
        }
#pragma unroll
        for (int g = 0; g < 4; ++g) { const f32x4 cb = *(const LAS f32x4*)(cs + 32 * T + 8 * g + 4 * hh);
#pragma unroll
            for (int e = 0; e < 4; ++e) s[4 * g + e] += cq - cb[e]; }
        if (T == 64) {
#pragma unroll
            for (int i = 0; i < 16; ++i) { const int kl = (i & 3) + 8 * (i >> 2) + 4 * hh; if (kl > qi) s[i] = -INFINITY; }
        }
        float mx = s[0];
#pragma unroll
        for (int i = 1; i < 16; ++i) mx = fmaxf(mx, s[i]);
        mx = fmaxf(mx, __shfl_xor(mx, 32));
        const float mnew = fmaxf(m, mx), alpha = __builtin_amdgcn_exp2f(m - mnew); m = mnew;
        float ps = 0.f;
#pragma unroll
        for (int i = 0; i < 16; ++i) { s[i] = __builtin_amdgcn_exp2f(s[i] - mnew); ps += s[i]; }
        lsum = lsum * alpha + ps;
        if (c < 16) {
#pragma unroll
            for (int i = 0; i < 16; ++i) { const int kl = (i & 3) + 8 * (i >> 2) + 4 * hh; Pw[kl * 16 + c] = s[i]; }
            if (hh == 0) Aw[c] = alpha;
        }
        asm volatile("s_waitcnt lgkmcnt(0)" ::: "memory"); __builtin_amdgcn_wave_barrier();
        {
            f32x4 a4[4];
#pragma unroll
            for (int j = 0; j < 4; ++j) a4[j] = *(const LAS f32x4*)(Aw + 4 * j);
#pragma unroll
            for (int q = 0; q < 16; ++q) { oa[q][0] *= a4[q >> 2][q & 3]; oa[q][1] *= a4[q >> 2][q & 3]; }
        }
        if (T < 64) {
            const float* vp = F.cV + (((size_t)b * PAST + 32 * T) * NH + h) * DH + 2 * lane;
#pragma unroll 4
            for (int kl = 0; kl < 32; ++kl) {
                const f32x2 v2 = *(const GAS f32x2*)(vp + (size_t)kl * NH * DH);
                f32x4 p4[4];
#pragma unroll
                for (int j = 0; j < 4; ++j) p4[j] = *(const LAS f32x4*)(Pw + kl * 16 + 4 * j);
#pragma unroll
                for (int q = 0; q < 16; ++q) { const float p = p4[q >> 2][q & 3]; oa[q][0] += p * v2.x; oa[q][1] += p * v2.y; }
            }
        } else {
            const bf16* vp = F.VB + (size_t)(SEQ + b * DECT) * D + h * DH + 2 * lane;
#pragma unroll 4
            for (int kl = 0; kl < 16; ++kl) {
                const unsigned vw = *(const GAS unsigned*)(vp + (size_t)kl * D);
                const float vx = bf_lo(vw), vy = bf_hi(vw);
                f32x4 p4[4];
#pragma unroll
                for (int j = 0; j < 4; ++j) p4[j] = *(const LAS f32x4*)(Pw + kl * 16 + 4 * j);
#pragma unroll
                for (int q = 0; q < 16; ++q) { const float p = p4[q >> 2][q & 3]; oa[q][0] += p * vx; oa[q][1] += p * vy; }
            }
        }
        asm volatile("s_waitcnt lgkmcnt(0)" ::: "memory"); __builtin_amdgcn_wave_barrier();
    }
    {
        const float ltot = lsum + __shfl_xor(lsum, 32);
        LAS float* Mb = (LAS float*)(lds + SA_M); LAS float* Lb = (LAS float*)(lds + SA_L); LAS float* Ob = (LAS float*)(lds + SA_O);
        if (lane < 16) { Mb[w * 16 + lane] = m; Lb[w * 16 + lane] = ltot; }
#pragma unroll
        for (int q = 0; q < 16; ++q) *(LAS f32x2*)(Ob + (w * 16 + q) * 128 + 2 * lane) = (f32x2){oa[q][0], oa[q][1]};
        __syncthreads();
#pragma unroll
        for (int i = 0; i < 4; ++i) {
            const int idx = tid + 512 * i, q = idx >> 7, d = idx & 127;
            float mx = Mb[q];
#pragma unroll
            for (int ww = 1; ww < 8; ++ww) mx = fmaxf(mx, Mb[ww * 16 + q]);
            float L = 0.f, ov = 0.f;
#pragma unroll
            for (int ww = 0; ww < 8; ++ww) { const float sc = __builtin_amdgcn_exp2f(Mb[ww * 16 + q] - mx); L += Lb[ww * 16 + q] * sc; ov += Ob[(ww * 16 + q) * 128 + d] * sc; }
            F.OB[(size_t)(SEQ + b * DECT + q) * D + h * DH + d] = (bf16)f2bf(ov / L);
        }
        __syncthreads();
    }
}

constexpr int NPHASE = 21;
struct Args { const float* in[16]; float* out; unsigned char* ws; int ph_lo, ph_hi; };
__global__ void __launch_bounds__(NWAVES * 64, 2) trunk_fwd(Args args) {
    extern __shared__ __attribute__((aligned(16))) unsigned char lds[];
    Frame F;
    F.lds = (LAS unsigned char*)lds;
    const int wave_s = __builtin_amdgcn_readfirstlane((int)threadIdx.x >> 6);
#define REFRESH() do { unsigned _z = 0u; asm volatile("" : "+s"(_z)); const int _l = (int)__builtin_amdgcn_mbcnt_hi(~0u, __builtin_amdgcn_mbcnt_lo(~0u, _z)); F.lane = _l; F.wave = wave_s; F.tid = wave_s * 64 + _l; } while (0)
    REFRESH();
    F.G = gridDim.x; { const int bx = blockIdx.x; F.vcu = (F.G % 8 == 0) ? (bx % 8) * (F.G / 8) + bx / 8 : bx; }
    unsigned char* ws = args.ws;
    F.xP = args.in[0]; F.xS = args.in[1]; F.spool = args.in[2]; F.cK = args.in[3]; F.cV = args.in[4]; F.cLF = args.in[5]; F.lng = args.in[6]; F.lnb = args.in[7];
    F.w1 = args.in[8]; F.w3 = args.in[9]; F.w2 = args.in[10]; F.poolw = args.in[11]; F.pools = args.in[12]; F.win = args.in[13]; F.bfg = args.in[14]; F.wo = args.in[15];
    F.out = args.out; F.ctl = (unsigned*)(ws + WS_CTL);
    F.W13 = (bf16*)(ws + WS_W13); F.W2T = (bf16*)(ws + WS_W2T); F.WIN = (bf16*)(ws + WS_WIN); F.WO = (bf16*)(ws + WS_WO); F.POOLT = (bf16*)(ws + WS_POOLT);
    F.S = (float*)(ws + WS_S); F.XBF = (bf16*)(ws + WS_XBF); F.HB = (bf16*)(ws + WS_HB); F.DB = (bf16*)(ws + WS_DB);
    F.QB = (bf16*)(ws + WS_QB); F.KB = (bf16*)(ws + WS_KB); F.VB = (bf16*)(ws + WS_VB); F.VT = (bf16*)(ws + WS_VT); F.OB = (bf16*)(ws + WS_OB); F.CL = (float*)(ws + WS_CL);
    for (int u = F.tid; u < (LDS_BYTES - LDSCTL_OFF) / 4; u += NWAVES * 64) ((LAS unsigned*)(F.lds + LDSCTL_OFF))[u] = 0u;
    __syncthreads();
    volatile LAS unsigned* MISC = (volatile LAS unsigned*)(F.lds + MISC_OFF);
    XcdBarrier bar; bar.bar = (unsigned*)(ws + WS_CTL) + CW_BAR; bar.x = 0; bar.st = nullptr;
    if (!MK_SPLIT) bar = xcd_barrier_post((unsigned*)(ws + WS_CTL) + CW_BAR, MISC + 8, F.tid);
    const int lo = args.ph_lo, hi = args.ph_hi;
#ifdef ONLY_PHASE
#define IN(k) ((k) == ONLY_PHASE && lo <= (k) && (k) < hi)
#else
#define IN(k) (lo <= (k) && (k) < hi)
#endif
#define SEAM(k) do { if (IN(k) && IN((k) + 1)) xcd_barrier(bar, F.tid); REFRESH(); } while (0)
#define UP_PHASE(k, f) if (IN(k)) { pg8::Gemm g{F.XBF, F.W13 + (size_t)(f) * 2 * FF * D, D, D, D}; pg8::StaticOrder S; S.init(M, 2 * FF, F.G, (int)blockIdx.x); \
        pg8::EpiSwiglu E{F.HB}; pg8::gemm_phase<pg8::EpiSwiglu, pg8::StaticOrder>(F.lds + RING_OFF, g, S, E, F.tid); } SEAM(k)
#define DOWN_PHASE(k, f, sp, ss) if (IN(k)) { pg8::Gemm g{F.HB, F.W2T + (size_t)(f) * D * FF, FF, FF, FF}; pg8::StaticOrder S; S.init(M, D, F.G, (int)blockIdx.x); \
        pg8::EpiResid E{F.S, (sp), (ss), 0.5f, nullptr}; pg8::gemm_phase<pg8::EpiResid, pg8::StaticOrder>(F.lds + RING_OFF, g, S, E, F.tid); } SEAM(k)

    if (IN(0)) { p0_prologue(F); } SEAM(0);
    UP_PHASE(1, 0);
    DOWN_PHASE(2, 0, F.xP, F.xS);
    if (IN(3)) { ln_pass<false, true, false, false>(F, F.lng + 0 * D, F.lnb + 0 * D); } SEAM(3);
    if (IN(4)) { pool_pass(F); } SEAM(4);
    if (IN(5)) { pg8::Gemm g{F.DB, F.POOLT, D, 512, 512}; pg8::StaticOrder S; S.init(M, D, F.G, (int)blockIdx.x, 2, 512 * 2);
        pg8::EpiResid E{F.S, F.S, F.S + (size_t)SEQ * D, 1.0f, F.pools}; pg8::gemm_phase<pg8::EpiResid, pg8::StaticOrder>(F.lds + RING_OFF, g, S, E, F.tid); } SEAM(5);
    if (IN(6)) { ln_pass<true, false, false, false>(F, F.lng + 1 * D, F.lnb + 1 * D); } SEAM(6);
    UP_PHASE(7, 1);
    DOWN_PHASE(8, 1, F.S, F.S + (size_t)SEQ * D);
    if (IN(9)) { ln_pass<true, false, false, false>(F, F.lng + 2 * D, F.lnb + 2 * D); } SEAM(9);
    UP_PHASE(10, 2);
    DOWN_PHASE(11, 2, F.S, F.S + (size_t)SEQ * D);
    if (IN(12)) { ln_pass<true, false, true, false>(F, F.lng + 3 * D, F.lnb + 3 * D); } SEAM(12);
    if (IN(13)) { pg8::Gemm g{F.XBF, F.WIN, D, D, D}; pg8::StaticOrder S; S.init(M, 3 * D, F.G, (int)blockIdx.x);
        pg8::EpiQKV E{F.QB, (size_t)(WS_KB - WS_QB) / 2, F.out + O_KP, F.out + O_KS}; pg8::gemm_phase<pg8::EpiQKV, pg8::StaticOrder>(F.lds + RING_OFF, g, S, E, F.tid); } SEAM(13);
    if (IN(14)) { scan_vt_pass(F); } SEAM(14);
    if (IN(15)) {
#if !defined(ATT_ONLY) || ATT_ONLY == 1
        for (int p = F.vcu; p < NH * 32; p += F.G) { const int h = p >> 5, x = p & 31;
            for (int half = 0; half < 2; ++half) attn_prompt_unit(F, h, half ? 63 - x : x); }
#endif
#if !defined(ATT_ONLY) || ATT_ONLY == 2
        for (int u = F.vcu; u < DECB * NH; u += F.G) attn_sample_unit(F, u >> 4, u & 15);
#endif
    } SEAM(15);
    if (IN(16)) { pg8::Gemm g{F.OB, F.WO, D, D, D}; pg8::StaticOrder S; S.init(M, D, F.G, (int)blockIdx.x);
        pg8::EpiResid E{F.S, F.S, F.S + (size_t)SEQ * D, 1.0f, nullptr}; pg8::gemm_phase<pg8::EpiResid, pg8::StaticOrder>(F.lds + RING_OFF, g, S, E, F.tid); } SEAM(16);
    if (IN(17)) { ln_pass<true, false, false, false>(F, F.lng + 4 * D, F.lnb + 4 * D); } SEAM(17);
    UP_PHASE(18, 3);
    DOWN_PHASE(19, 3, F.S, F.S + (size_t)SEQ * D);
    if (IN(20)) { ln_pass<false, false, false, true>(F, F.lng + 5 * D, F.lnb + 5 * D); }
#undef IN
#undef SEAM
#undef UP_PHASE
#undef DOWN_PHASE
}

extern "C" void kernel_launch(void* const* d_in, const int* in_sizes, int n_in, void* d_out, int out_size, void* d_ws, size_t ws_size, hipStream_t stream) {
    static int grid = 0;
    if (grid == 0) {
        if (n_in != 16 || (size_t)out_size != O_END || ws_size < WS_END) { fprintf(stderr, "kernel_launch: unexpected shapes (n_in %d, out %d, ws %zu)\n", n_in, out_size, ws_size); grid = -1; return; }
        int dev = 0, cus = 0, per_cu = 0;
        if (hipGetDevice(&dev) != hipSuccess || hipDeviceGetAttribute(&cus, hipDeviceAttributeMultiprocessorCount, dev) != hipSuccess) { grid = -1; return; }
        if (hipFuncSetAttribute((const void*)trunk_fwd, hipFuncAttributeMaxDynamicSharedMemorySize, LDS_BYTES) != hipSuccess) { fprintf(stderr, "kernel_launch: hipFuncSetAttribute failed\n"); grid = -1; return; }
        if (hipOccupancyMaxActiveBlocksPerMultiprocessor(&per_cu, (const void*)trunk_fwd, NWAVES * 64, LDS_BYTES) != hipSuccess || per_cu < 1)
            fprintf(stderr, "kernel_launch: occupancy query reports %d workgroups per CU\n", per_cu);
        (void)hipGetLastError();
        grid = cus;
    }
    if (grid < 0) return;
    (void)hipMemsetAsync((char*)d_ws + WS_CTL, 0, CTL_ZERO_BYTES, stream);
    Args a{};
    for (int i = 0; i < 16; ++i) a.in[i] = (const float*)d_in[i];
    a.out = (float*)d_out; a.ws = (unsigned char*)d_ws;
#if MK_SPLIT
    for (int k = 0; k < NPHASE; ++k) { a.ph_lo = k; a.ph_hi = k + 1; hipLaunchKernelGGL(trunk_fwd, dim3(grid), dim3(NWAVES * 64), LDS_BYTES, stream, a); }
#else
    a.ph_lo = 0; a.ph_hi = NPHASE; hipLaunchKernelGGL(trunk_fwd, dim3(grid), dim3(NWAVES * 64), LDS_BYTES, stream, a);
#endif
}
```

```cpp
#include <hip/hip_runtime.h>
#include <cstdio>
#include <cstdint>

#ifndef MK_SPLIT
#define MK_SPLIT 0
#endif

#define LAS __attribute__((address_space(3)))
#define GAS __attribute__((address_space(1)))
typedef unsigned short bf16;
typedef short bf16x8 __attribute__((ext_vector_type(8)));
typedef float f32x4 __attribute__((ext_vector_type(4)));
typedef float f32x2 __attribute__((ext_vector_type(2)));
typedef float f32x16 __attribute__((ext_vector_type(16)));
typedef unsigned u32x4 __attribute__((ext_vector_type(4)));
typedef unsigned u32x2 __attribute__((ext_vector_type(2)));
typedef unsigned v4u __attribute__((ext_vector_type(4)));
typedef __bf16 bf16x2_t __attribute__((ext_vector_type(2)));

constexpr int D = 2048, SEQ = 16384, NS = 512, M = SEQ + NS, FF = 8192, NH = 16, DH = 128, PAST = 2048, DECB = 32, DECT = 16, PST = 15;
constexpr int FFP = FF + 64;
constexpr int WIN_LD = 3 * D + NH;
constexpr float ALPHA = 1.41421356237309515f, LN_EPS = 1e-5f;
constexpr float LOG2E = 1.4426950408889634f;
constexpr float QSCALE = 0.08838834764831845f * 1.4426950408889634f;

constexpr size_t O_YP = 0, O_YS = 33554432, O_PP = 34603008, O_PS = 34633728, O_KP = 35616768, O_VP = 69171200, O_LP = 102725632, O_KS = 102987776, O_VS = 104036352, O_LS = 105084928, O_END = 105093120;

constexpr size_t MiB = 1u << 20;
constexpr size_t WS_CTL = 0, CTL_ZERO_BYTES = 1 * MiB;
constexpr size_t WS_W13 = 2 * MiB;
constexpr size_t WS_W2T = 258 * MiB;
constexpr size_t WS_WIN = 388 * MiB;
constexpr size_t WS_WO = 412 * MiB;
constexpr size_t WS_POOLT = 420 * MiB;
constexpr size_t WS_S = 422 * MiB;
constexpr size_t WS_XBF = 554 * MiB;
constexpr size_t WS_HB = 620 * MiB;
constexpr size_t WS_DB = 888 * MiB;
constexpr size_t WS_QB = 954 * MiB, WS_KB = 1020 * MiB, WS_VB = 1086 * MiB;
constexpr size_t WS_VT = 1152 * MiB;
constexpr size_t WS_OB = 1216 * MiB;
constexpr size_t WS_CL = 1282 * MiB;
constexpr size_t WS_ZS = 1283 * MiB;
constexpr size_t WS_ST = 1287 * MiB;
constexpr size_t WS_SLAB = 1289 * MiB;
constexpr size_t WS_END = 1321 * MiB;
static_assert(WS_W2T + (size_t)4 * D * FFP * 2 <= WS_WIN && WS_HB + (size_t)M * FFP * 2 <= WS_DB && WS_VB - WS_KB == WS_KB - WS_QB, "d_ws map");
constexpr int CW_TMO = 0, CW_BAR = 4096, CW_KMAX = 65536, CW_VTQ = 8256, CW_Q1 = 8320, CW_Q2 = 8384, CW_CQ = 8448, CW_CD = 8768, CW_DY = 9088;
constexpr float SKIP_THR = 28.0f;

namespace pg8 {
constexpr int BM = 256, BK = 64, HALF = 128, HTB = HALF * BK * 2, STAGE_BYTES = 8 * HTB, NXCD = 8, WGM = 8;
__host__ __device__ __forceinline__ int lds_byte(int r, int c) { const int st = (r >> 4) * 2 + (c >> 5), rr = r & 15, cc = c & 31, ob = rr * 64 + cc * 2; return st * 1024 + (ob ^ (((ob >> 9) & 1) << 5)); }
__host__ __device__ __forceinline__ void stage_rc(int b, int& R, int& C) { const int st = b / 1024, sb = b % 1024, swz = sb ^ (((sb >> 9) & 1) << 5); R = (st >> 1) * 16 + swz / 64; C = (st & 1) * 32 + (swz % 64) / 2; }
__host__ __device__ __forceinline__ int perm32(int rho) { const int n = rho >> 4, i = rho & 15; return 8 * (i >> 2) + 4 * n + (i & 3); }

struct Unit { int pm, pn, ks, nt; };
struct Gemm { const bf16* A; const bf16* Bt; int lda, ldb, K; size_t kstepA, kstepB; };

struct StaticOrder {
    int nM, nN, nwg, G, c, gdiv; unsigned gkb; int ksplit, ksub, nsub, nsub_c, ntfull, wgm, pmoff;
    __device__ __forceinline__ void init(int Mrows, int N_, int G_, int c_, int Kfull, int gdiv_ = 0, unsigned gkb_ = 0, int ksplit_ = 0, int wgm_ = WGM, int pmoff_ = 0) {
        pmoff = pmoff_; wgm = wgm_; nN = N_ / BM; G = G_; c = c_; gdiv = gdiv_; gkb = gkb_; ksplit = ksplit_; ntfull = Kfull / BK;
        if (ksplit) { nM = SEQ / BM; ksub = Kfull / ksplit; nsub = (NS / BM) * nN * ksplit; nsub_c = (c < nsub) ? (nsub - c + G - 1) / G : 0; }
        else { nM = Mrows / BM; ksub = 0; nsub = 0; nsub_c = 0; }
        nwg = nM * nN;
    }
    int dynL = 0x7fffffff; unsigned* dynw = nullptr; LAS unsigned* dynl = nullptr;
    __device__ __forceinline__ void decode(int L, Unit& u) const {
        int wgid = L; { const int q = nwg / NXCD, r = nwg % NXCD, xcd = wgid % NXCD, off = wgid / NXCD; wgid = (xcd < r ? xcd * (q + 1) : r * (q + 1) + (xcd - r) * q) + off; }
        const int nig = wgm * nN, gid = wgid / nig, fm = gid * wgm, gsz = (nM - fm) < wgm ? (nM - fm) : wgm;
        u.pm = pmoff + fm + ((wgid % nig) % gsz); u.pn = (wgid % nig) / gsz; u.ks = -1; u.nt = ntfull;
    }
    __device__ __forceinline__ bool next(int i, Unit& u) const {
        if (i < nsub_c) { const int L = i * G + c; u.ks = L % ksplit; const int t = L / ksplit; u.pn = t % nN; u.pm = SEQ / BM + t / nN; u.nt = ksub / BK; return true; }
        const long L = (long)(i - nsub_c) * G + c; if (L >= nwg || L >= dynL) return false;
        decode((int)L, u); return true;
    }
    __device__ __forceinline__ bool claim(Unit& u, int tid) const {
        const int nx = (G >= 2 * NXCD) ? NXCD : 1, xl = c % nx;
        if (tid == 0) { const unsigned v = __hip_atomic_fetch_add(dynw + xl, 1u, __ATOMIC_RELAXED, __HIP_MEMORY_SCOPE_AGENT); *dynl = v; asm volatile("s_waitcnt lgkmcnt(0)" ::: "memory"); }
        asm volatile("" ::: "memory"); __builtin_amdgcn_s_barrier(); asm volatile("" ::: "memory");
        const long L = (long)dynL + (long)nx * (long)*dynl + (long)xl;
        if (L >= nwg) return false;
        decode((int)L, u); return true;
    }
    __device__ __forceinline__ size_t a_goff(const Unit& u) const { return gdiv ? (size_t)(u.pn / gdiv) * gkb : (size_t)0; }
    __device__ __forceinline__ int ktile0(const Unit& u) const { return u.ks > 0 ? u.ks * (ksub / BK) : 0; }
};

__device__ __forceinline__ unsigned cvt_pk_bf16(float lo, float hi) { unsigned r; asm volatile("v_cvt_pk_bf16_f32 %0, %1, %2" : "=v"(r) : "v"(lo), "v"(hi)); return r; }


struct EpiSwiglu {
    static constexpr bool PERM = true;
    bf16* Hout;
    __device__ __forceinline__ void operator()(const f32x4 (&acc)[2][2][4][2], const Unit& u, int wr, int wc, int fr, int fq) const {
        const int row0 = u.pm * BM + wr * 64 + fr, col0 = u.pn * HALF + wc * 32 + 8 * fq;
#pragma unroll
        for (int ai = 0; ai < 2; ++ai)
#pragma unroll
            for (int m = 0; m < 4; ++m) {
                bf16* rowp = Hout + ((size_t)(col0 >> 6) * M + (row0 + ai * HALF + m * 16)) * 64 + (col0 & 63);
                float hv[8];
#pragma unroll
                for (int n = 0; n < 2; ++n)
#pragma unroll
                    for (int j = 0; j < 4; ++j) { const float a = acc[ai][0][m][n][j], b = acc[ai][1][m][n][j];
                        const float sg = __builtin_amdgcn_rcpf(1.0f + __builtin_amdgcn_exp2f(-a * LOG2E)); hv[n * 4 + j] = a * sg * b; }
                u32x4 w; w.x = cvt_pk_bf16(hv[0], hv[1]); w.y = cvt_pk_bf16(hv[2], hv[3]); w.z = cvt_pk_bf16(hv[4], hv[5]); w.w = cvt_pk_bf16(hv[6], hv[7]);
                *(u32x4*)rowp = w; }
    }
};
struct EpiResid {
    static constexpr bool PERM = true;
    float* S; const float* srcP; const float* srcS; float r; const float* cs; float* Zs;
    float* slab;
    const float* st; const float* lg; const float* lb;
    const bf16* xb = nullptr;
    __device__ __forceinline__ void operator()(const f32x4 (&acc)[2][2][4][2], const Unit& u, int wr, int wc, int fr, int fq) const {
        const int col0 = u.pn * BM + wc * 32 + 8 * fq; const int rowb = u.pm * BM + wr * 64 + fr;
        if (u.ks >= 0) {
            bf16* zb = (bf16*)slab + ((size_t)u.ks * NS + (rowb - SEQ)) * D + col0;
#pragma unroll
            for (int bj = 0; bj < 2; ++bj) {
                f32x4 s0 = cs ? *(const f32x4*)(cs + col0 + bj * HALF) : (f32x4){1.f, 1.f, 1.f, 1.f}, s1 = cs ? *(const f32x4*)(cs + col0 + bj * HALF + 4) : (f32x4){1.f, 1.f, 1.f, 1.f}; s0 = s0 * r; s1 = s1 * r;
#pragma unroll
                for (int ai = 0; ai < 2; ++ai)
#pragma unroll
                    for (int m = 0; m < 4; ++m) { const f32x4 o0 = acc[ai][bj][m][0] * s0, o1 = acc[ai][bj][m][1] * s1;
                        u32x4 w; w.x = cvt_pk_bf16(o0[0], o0[1]); w.y = cvt_pk_bf16(o0[2], o0[3]); w.z = cvt_pk_bf16(o1[0], o1[1]); w.w = cvt_pk_bf16(o1[2], o1[3]);
                        *(u32x4*)(zb + (size_t)(ai * HALF + m * 16) * D + bj * HALF) = w; } }
            return;
        }
        const bool prm = u.pm < SEQ / BM;
        const float* src = prm ? srcP : (srcS - (size_t)SEQ * D);
        float* dst = prm ? S : (Zs - (size_t)SEQ * D);
        f32x4 sc[2][2];
#pragma unroll
        for (int bj = 0; bj < 2; ++bj)
#pragma unroll
            for (int n = 0; n < 2; ++n) { sc[bj][n] = cs ? *(const f32x4*)(cs + col0 + bj * HALF + 4 * n) : (f32x4){1.f, 1.f, 1.f, 1.f}; sc[bj][n] = sc[bj][n] * r; }
        if (st != nullptr && prm) {
            const unsigned offb = (unsigned)rowb * (unsigned)D + (unsigned)col0;
#pragma unroll
            for (int ai = 0; ai < 2; ++ai) {
                f32x2 ms[4];
#pragma unroll
                for (int m = 0; m < 4; ++m) ms[m] = *(const f32x2*)(st + 2u * (unsigned)(rowb + ai * HALF + m * 16));
#pragma unroll
                for (int bj = 0; bj < 2; ++bj) { const unsigned co = (unsigned)(bj * HALF);
                    const f32x4 g0 = *(const f32x4*)(lg + col0 + co) * ALPHA, g1 = *(const f32x4*)(lg + col0 + co + 4) * ALPHA, b0 = *(const f32x4*)(lb + col0 + co) * ALPHA, b1 = *(const f32x4*)(lb + col0 + co + 4) * ALPHA;
                    u32x4 zr[4];
#pragma unroll
                    for (int m = 0; m < 4; ++m) zr[m] = *(const u32x4*)((const bf16*)src + (offb + (unsigned)((ai * HALF + m * 16) * D) + co));
#pragma unroll
                    for (int m = 0; m < 4; ++m) { const u32x4 zq = zr[m];
                        const f32x4 z0 = {__builtin_bit_cast(float, zq.x << 16), __builtin_bit_cast(float, zq.x & 0xffff0000u), __builtin_bit_cast(float, zq.y << 16), __builtin_bit_cast(float, zq.y & 0xffff0000u)};
                        const f32x4 z1 = {__builtin_bit_cast(float, zq.z << 16), __builtin_bit_cast(float, zq.z & 0xffff0000u), __builtin_bit_cast(float, zq.w << 16), __builtin_bit_cast(float, zq.w & 0xffff0000u)};
                        const f32x4 o0 = (z0 - ms[m].x) * ms[m].y * g0 + b0 + acc[ai][bj][m][0] * sc[bj][0], o1 = (z1 - ms[m].x) * ms[m].y * g1 + b1 + acc[ai][bj][m][1] * sc[bj][1];
                        u32x4 w; w.x = cvt_pk_bf16(o0[0], o0[1]); w.y = cvt_pk_bf16(o0[2], o0[3]); w.z = cvt_pk_bf16(o1[0], o1[1]); w.w = cvt_pk_bf16(o1[2], o1[3]);
                        *(u32x4*)((bf16*)dst + (offb + (unsigned)((ai * HALF + m * 16) * D) + co)) = w; }
                    asm volatile("" ::: "memory"); } }
            return;
        }
#pragma unroll
        for (int ai = 0; ai < 2; ++ai)
#pragma unroll
            for (int m = 0; m < 4; ++m) { const size_t off = (size_t)(rowb + ai * HALF + m * 16) * D + col0;
#pragma unroll
                for (int bj = 0; bj < 2; ++bj) { f32x4 x0, x1;
                    if (prm && xb != nullptr) { const u32x4 xq = *(const u32x4*)(xb + off + bj * HALF);
                        x0 = (f32x4){__builtin_bit_cast(float, xq.x << 16), __builtin_bit_cast(float, xq.x & 0xffff0000u), __builtin_bit_cast(float, xq.y << 16), __builtin_bit_cast(float, xq.y & 0xffff0000u)};
                        x1 = (f32x4){__builtin_bit_cast(float, xq.z << 16), __builtin_bit_cast(float, xq.z & 0xffff0000u), __builtin_bit_cast(float, xq.w << 16), __builtin_bit_cast(float, xq.w & 0xffff0000u)}; }
                    else { x0 = *(const f32x4*)(src + off + bj * HALF); x1 = *(const f32x4*)(src + off + bj * HALF + 4); }
                    const f32x4 o0 = x0 * ALPHA + acc[ai][bj][m][0] * sc[bj][0], o1 = x1 * ALPHA + acc[ai][bj][m][1] * sc[bj][1];
                    if (prm) { u32x4 w; w.x = cvt_pk_bf16(o0[0], o0[1]); w.y = cvt_pk_bf16(o0[2], o0[3]); w.z = cvt_pk_bf16(o1[0], o1[1]); w.w = cvt_pk_bf16(o1[2], o1[3]);
                        *(u32x4*)((bf16*)dst + off + bj * HALF) = w; }
                    else { *(f32x4*)(dst + off + bj * HALF) = o0; *(f32x4*)(dst + off + bj * HALF + 4) = o1; } }
                asm volatile("" ::: "memory"); }
    }
};
struct EpiQKV {
    static constexpr bool PERM = false;
    bf16* Q; size_t bstride; float *kP, *kS; bf16* VT; unsigned* kq;
    __device__ __forceinline__ void operator()(const f32x4 (&acc)[2][2][4][2], const Unit& u, int wr, int wc, int fr, int fq) const {
        const int t = u.pn >> 3, colt = (u.pn & 7) * BM; const int rowb = u.pm * BM + wr * 64 + fr, col0 = colt + wc * 32 + 4 * fq;
        const int colb = colt + wc * 32 + ((fq & 1) ? 16 + 4 * (fq - 1) : 4 * fq);
        bf16* ob = Q + (size_t)t * bstride;
        const size_t tv = (t == 2) ? 1 : 0;
        float* of = (rowb < SEQ) ? (kP + tv * (O_VP - O_KP)) : (kS + tv * (O_VS - O_KS) - (size_t)SEQ * D);
        const float sc = (t == 0) ? QSCALE : 1.0f;
#pragma unroll
        for (int ai = 0; ai < 2; ++ai)
#pragma unroll
            for (int m = 0; m < 4; ++m) { const size_t off = (size_t)(rowb + ai * HALF + m * 16) * D + col0;
#pragma unroll
                for (int bj = 0; bj < 2; ++bj) { const f32x4 v0 = acc[ai][bj][m][0], v1 = acc[ai][bj][m][1];
                    if (t != 2 || rowb >= SEQ) {
                        unsigned a0 = cvt_pk_bf16(v0[0] * sc, v0[1] * sc), a1 = cvt_pk_bf16(v0[2] * sc, v0[3] * sc), b0 = cvt_pk_bf16(v1[0] * sc, v1[1] * sc), b1 = cvt_pk_bf16(v1[2] * sc, v1[3] * sc);
                        { auto r0 = __builtin_amdgcn_permlane16_swap(a0, b0, false, false); a0 = r0[0]; b0 = r0[1]; }
                        { auto r1 = __builtin_amdgcn_permlane16_swap(a1, b1, false, false); a1 = r1[0]; b1 = r1[1]; }
                        u32x4 w; w.x = a0; w.y = a1; w.z = b0; w.w = b1;
                        *(u32x4*)(ob + (size_t)(rowb + ai * HALF + m * 16) * D + colb + bj * HALF) = w; }
                    if (t != 0) { *(f32x4*)(of + off + bj * HALF) = v0; *(f32x4*)(of + off + bj * HALF + 16) = v1; } } }
        if (t == 1 && rowb < SEQ) {
#pragma unroll
            for (int bj = 0; bj < 2; ++bj) { float mx = 0.f;
#pragma unroll
                for (int ai = 0; ai < 2; ++ai)
#pragma unroll
                    for (int m = 0; m < 4; ++m) { float s = 0.f;
#pragma unroll
                        for (int n = 0; n < 2; ++n)
#pragma unroll
                            for (int j = 0; j < 4; ++j) { const float kb = __builtin_bit_cast(float, cvt_pk_bf16(0.f, acc[ai][bj][m][n][j]) & 0xffff0000u); s += kb * kb; }
                        s += __shfl_xor(s, 16); s += __shfl_xor(s, 32); mx = fmaxf(mx, s); }
                mx = fmaxf(mx, __shfl_xor(mx, 1)); mx = fmaxf(mx, __shfl_xor(mx, 2)); mx = fmaxf(mx, __shfl_xor(mx, 4)); mx = fmaxf(mx, __shfl_xor(mx, 8));
                if (fr == 0 && fq == 0) kq[((((colt + bj * HALF) >> 7) * 4 + wc) * (SEQ / BM) + u.pm) * 2 + wr] = __float_as_uint(mx); }
        }
        if (t == 2 && rowb < SEQ) {
            bf16* vt = VT; const int qi = fr & 3; const bool od1 = (qi & 1) != 0, od2 = (qi & 2) != 0;
#define QX1(x) __builtin_bit_cast(float, __builtin_amdgcn_mov_dpp(__builtin_bit_cast(int, (x)), 0xB1, 0xF, 0xF, true))
#define QX2(x) __builtin_bit_cast(float, __builtin_amdgcn_mov_dpp(__builtin_bit_cast(int, (x)), 0x4E, 0xF, 0xF, true))
#pragma unroll
            for (int bj = 0; bj < 2; ++bj)
#pragma unroll
                for (int n = 0; n < 2; ++n) { const int dg = col0 + bj * HALF + 16 * n + qi, h = dg >> 7, d = dg & 127;
#pragma unroll
                    for (int ai = 0; ai < 2; ++ai)
#pragma unroll
                        for (int m = 0; m < 4; ++m) { const f32x4 a = acc[ai][bj][m][n];
                            const float r0 = QX1(od1 ? a[0] : a[1]), r1 = QX1(od1 ? a[2] : a[3]);
                            const float lo0 = od1 ? r0 : a[0], hi0 = od1 ? a[1] : r0;
                            const float lo1 = od1 ? r1 : a[2], hi1 = od1 ? a[3] : r1;
                            const float t0 = QX2(od2 ? lo0 : lo1), t1 = QX2(od2 ? hi0 : hi1);
                            const float w0 = od2 ? t0 : lo0, w1 = od2 ? t1 : hi0, w2 = od2 ? lo1 : t0, w3 = od2 ? hi1 : t1;
                            const int s4 = (rowb - qi) + ai * HALF + m * 16;
                            u32x2 pk; pk.x = cvt_pk_bf16(w0, w1); pk.y = cvt_pk_bf16(w2, w3);
                            *(u32x2*)(vt + (((size_t)h * (SEQ / 64) + (s4 >> 6)) * DH + d) * 64 + (s4 & 63)) = pk; } }
#undef QX1
#undef QX2
        }
    }
};

template <class Epi, class Sched, bool ALIGN_EPI = true>
__device__ __forceinline__ void gemm_phase(LAS unsigned char* lds, const Gemm g, const Sched& S, const Epi& E, const int tid) {
    const int wid = __builtin_amdgcn_readfirstlane(tid >> 6), lane = tid & 63, wr = wid >> 2, wc = wid & 3, fr = lane & 15, fq = lane >> 4;
    unsigned voffA[2], voffB[2];
#pragma unroll
    for (int i = 0; i < 2; ++i) { int R, C; stage_rc(tid * 16 + i * 8192, R, C); const int Rb = Epi::PERM ? ((R & ~31) + perm32(R & 31)) : R;
        voffA[i] = (unsigned)(R * g.lda + C) * 2u; voffB[i] = (unsigned)(Rb * g.ldb + C) * 2u; }
    const size_t kstepA = g.kstepA, kstepB = g.kstepB;
    const size_t hstepA = (size_t)HALF * g.lda * 2, hstepB = (size_t)HALF * g.ldb * 2;
    const size_t tstepA = 2 * hstepA, tstepB = 2 * hstepB;
    const unsigned ldsw = (unsigned)wid * 1024u;
    const int aoff = lds_byte(wr * 64 + fr, fq * 8), boff = lds_byte(wc * 32 + fr, fq * 8);
#define PG8_SA(b, h) (((b) * 2 + (h)) * HTB)
#define PG8_SB(b, h) ((4 + (b) * 2 + (h)) * HTB)
#define PG8_STAGE(bufoff, gbase, voff) do { _Pragma("unroll") for (int _i = 0; _i < 2; ++_i) \
        __builtin_amdgcn_global_load_lds((const unsigned*)((const char*)(gbase) + (voff)[_i]), (LAS unsigned*)(lds + (bufoff) + ldsw + _i * 8192), 16, 0, 0); } while (0)
#define PG8_LDA(dst, b, h) do { _Pragma("unroll") for (int m = 0; m < 4; ++m) _Pragma("unroll") for (int k = 0; k < 2; ++k) dst[m][k] = *(const LAS bf16x8*)(lds + PG8_SA(b, h) + aoff + m * 2048 + k * 1024); } while (0)
#define PG8_LDB(dst, b, h) do { _Pragma("unroll") for (int n = 0; n < 2; ++n) _Pragma("unroll") for (int k = 0; k < 2; ++k) dst[n][k] = *(const LAS bf16x8*)(lds + PG8_SB(b, h) + boff + n * 2048 + k * 1024); } while (0)
#define PG8_MMA(ai, bj, At, Bt) do { __builtin_amdgcn_s_setprio(1); _Pragma("unroll") for (int m = 0; m < 4; ++m) _Pragma("unroll") for (int n = 0; n < 2; ++n) _Pragma("unroll") for (int k = 0; k < 2; ++k) \
        acc[ai][bj][m][n] = __builtin_amdgcn_mfma_f32_16x16x32_bf16(Bt[n][k], At[m][k], acc[ai][bj][m][n], 0, 0, 0); __builtin_amdgcn_s_setprio(0); } while (0)
#define PG8_WAIT_V(n) asm volatile("s_waitcnt vmcnt(" #n ")" ::: "memory")
#define PG8_WAIT_L(n) asm volatile("s_waitcnt lgkmcnt(" #n ")" ::: "memory")
#define PG8_BAR __builtin_amdgcn_s_barrier()
#define PG8_SCHED __builtin_amdgcn_sched_barrier(0)
    Unit cur, nxt; int ui = 0;
    if (!S.next(0, cur)) return;
    f32x4 acc[2][2][4][2];
#pragma unroll
    for (int a = 0; a < 2; ++a)
#pragma unroll
        for (int b = 0; b < 2; ++b)
#pragma unroll
            for (int m = 0; m < 4; ++m)
#pragma unroll
                for (int n = 0; n < 2; ++n) acc[a][b][m][n] = (f32x4){0.f, 0.f, 0.f, 0.f};
    bf16x8 At[4][2], B0[2][2], B1[2][2];
    const char* cA = (const char*)g.A + (size_t)cur.pm * tstepA + S.a_goff(cur) + (size_t)S.ktile0(cur) * kstepA; const char* cB = (const char*)g.Bt + (size_t)cur.pn * tstepB + (size_t)S.ktile0(cur) * kstepB;
    PG8_STAGE(PG8_SB(0, 0), cB, voffB); PG8_STAGE(PG8_SB(0, 1), cB + hstepB, voffB); PG8_STAGE(PG8_SA(0, 0), cA, voffA); PG8_STAGE(PG8_SA(0, 1), cA + hstepA, voffA);
    if (wr == 1) PG8_BAR;
    PG8_WAIT_V(2); PG8_BAR;
    PG8_STAGE(PG8_SB(1, 0), cB + kstepB, voffB); PG8_STAGE(PG8_SA(1, 0), cA + kstepA, voffA); PG8_STAGE(PG8_SB(1, 1), cB + hstepB + kstepB, voffB);
    PG8_WAIT_V(6); PG8_BAR;
    for (;;) {
        bool has_next = S.next(ui + 1, nxt);
        if (!has_next && S.dynw != nullptr) has_next = S.claim(nxt, tid);
        const char* nA = has_next ? (const char*)g.A + (size_t)nxt.pm * tstepA + S.a_goff(nxt) + (size_t)S.ktile0(nxt) * kstepA : cA; const char* nB = has_next ? (const char*)g.Bt + (size_t)nxt.pn * tstepB + (size_t)S.ktile0(nxt) * kstepB : cB;
        const int nt = cur.nt;
        for (int t = 0; t < nt; t += 2) {
            const bool last = (t == nt - 2);
            const char* a1 = cA + (size_t)(t + 1) * kstepA;
            const char* a2 = last ? nA : cA + (size_t)(t + 2) * kstepA; const char* b2 = last ? nB : cB + (size_t)(t + 2) * kstepB;
            const char* a3 = a2 + kstepA; const char* b3 = b2 + kstepB;
            PG8_LDB(B0, 0, 0); PG8_LDB(B1, 0, 1); PG8_SCHED; PG8_LDA(At, 0, 0); PG8_STAGE(PG8_SA(1, 1), a1 + hstepA, voffA);
            PG8_WAIT_V(8); PG8_WAIT_L(0); PG8_BAR; PG8_MMA(0, 0, At, B0); PG8_MMA(0, 1, At, B1); PG8_BAR; PG8_SCHED;
            PG8_LDA(At, 0, 1); PG8_STAGE(PG8_SB(0, 0), b2, voffB); PG8_STAGE(PG8_SB(0, 1), b2 + hstepB, voffB); PG8_STAGE(PG8_SA(0, 0), a2, voffA);
            PG8_WAIT_V(8); PG8_WAIT_L(0); PG8_BAR; PG8_MMA(1, 0, At, B0); PG8_MMA(1, 1, At, B1); PG8_BAR; PG8_SCHED;
            PG8_LDB(B0, 1, 0); PG8_LDB(B1, 1, 1); PG8_SCHED; PG8_LDA(At, 1, 0); PG8_STAGE(PG8_SA(0, 1), a2 + hstepA, voffA);
            PG8_WAIT_V(8); PG8_WAIT_L(0); PG8_BAR; PG8_MMA(0, 0, At, B0); PG8_MMA(0, 1, At, B1); PG8_BAR; PG8_SCHED;
            PG8_LDA(At, 1, 1); PG8_STAGE(PG8_SB(1, 0), b3, voffB); PG8_STAGE(PG8_SB(1, 1), b3 + hstepB, voffB); PG8_STAGE(PG8_SA(1, 0), a3, voffA);
            PG8_WAIT_V(8); PG8_WAIT_L(0); PG8_BAR; PG8_MMA(1, 0, At, B0); PG8_MMA(1, 1, At, B1); PG8_BAR; PG8_SCHED;
        }
        if constexpr (ALIGN_EPI) { if (wr == 0) PG8_BAR; }
        E(acc, cur, wr, wc, fr, fq);
        if (!has_next) break;
#pragma unroll
        for (int a = 0; a < 2; ++a)
#pragma unroll
            for (int b = 0; b < 2; ++b)
#pragma unroll
                for (int m = 0; m < 4; ++m)
#pragma unroll
                    for (int n = 0; n < 2; ++n) acc[a][b][m][n] = (f32x4){0.f, 0.f, 0.f, 0.f};
        cur = nxt; cA = nA; cB = nB; ++ui;
        if constexpr (ALIGN_EPI) { if (wr == 1) PG8_BAR; }
    }
    PG8_WAIT_V(0);
    if constexpr (!ALIGN_EPI) { if (wr == 0) PG8_BAR; }
    PG8_BAR;
#undef PG8_SA
#undef PG8_SB
#undef PG8_STAGE
#undef PG8_LDA
#undef PG8_LDB
#undef PG8_MMA
#undef PG8_WAIT_V
#undef PG8_WAIT_L
#undef PG8_BAR
#undef PG8_SCHED
}
}

constexpr int NWAVES = 8;
constexpr int RING_OFF = 0, RING_BYTES = 131072;
constexpr int LDSCTL_OFF = RING_BYTES, MISC_OFF = LDSCTL_OFF + 320;
constexpr int LDS_BYTES = 147456;

typedef GAS unsigned gu32;
#define RLX_AGENT __ATOMIC_RELAXED, __HIP_MEMORY_SCOPE_AGENT
#define LDS_WAIT() asm volatile("s_waitcnt lgkmcnt(0)" ::: "memory")
#define VM_WAIT() asm volatile("s_waitcnt vmcnt(0)" ::: "memory")
__device__ __forceinline__ unsigned f2bf(float f) { unsigned u = __builtin_bit_cast(unsigned, f); return (u + 0x7fffu + ((u >> 16) & 1u)) >> 16; }
__device__ __forceinline__ unsigned pk2(float lo, float hi) { return f2bf(lo) | (f2bf(hi) << 16); }
__device__ __forceinline__ unsigned cvtpk(float lo, float hi) { f32x2 v = {lo, hi}; bf16x2_t b = __builtin_convertvector(v, bf16x2_t); return __builtin_bit_cast(unsigned, b); }
__device__ __forceinline__ float bf_lo(unsigned w) { return __builtin_bit_cast(float, w << 16); }
__device__ __forceinline__ float bf_hi(unsigned w) { return __builtin_bit_cast(float, w & 0xffff0000u); }

#define XB_TMO      128
#define XB_XCNT(j)  (256  + 64 * (j))
#define XB_XSUB(j)  (1280 + 64 * (j))
#define XB_XGEN(j)  (2304 + 64 * (j))
#define XB_TOP      3328
#define XB_TOPGEN   3392
#define XCD_BAR_WORDS 3456
#define XB_SPIN_CAP (1u << 18)
__device__ __forceinline__ unsigned xb_ld(unsigned* p)              { return __hip_atomic_load(p, __ATOMIC_RELAXED, __HIP_MEMORY_SCOPE_AGENT); }
__device__ __forceinline__ unsigned xb_add(unsigned* p, unsigned v) { return __hip_atomic_fetch_add(p, v, __ATOMIC_RELAXED, __HIP_MEMORY_SCOPE_AGENT); }
__device__ __forceinline__ unsigned xb_xcc_id() { return (unsigned)__builtin_amdgcn_s_getreg((3 << 11) | 20) & 0xFu; }
#define XB_SPIN(cond, bar) do { unsigned _sp = 0; while (cond) { __builtin_amdgcn_s_sleep(1); \
    if ((++_sp & 255u) == 0u) { if (xb_ld(&(bar)[XB_TMO])) break; if (_sp > XB_SPIN_CAP) { atomicAdd(&(bar)[XB_TMO], 1u); break; } } } } while (0)
struct XcdBarrier { unsigned* bar; unsigned x; volatile LAS unsigned* st; };
__device__ __forceinline__ XcdBarrier xcd_barrier_post(unsigned* bar, volatile LAS unsigned* st, const int tid) {
    XcdBarrier b; b.bar = bar; b.x = xb_xcc_id(); b.st = st;
    if (tid == 0) (void)xb_add(&bar[XB_XCNT(b.x)], 1u);
    return b;
}
__device__ __forceinline__ void xcd_barrier_complete(unsigned* bar, unsigned x, unsigned& nloc, unsigned& nx) {
    const unsigned G = gridDim.x * gridDim.y * gridDim.z;
    unsigned sum, cnt, mine, sp = 0u;
    for (;;) {
        sum = 0u; cnt = 0u; mine = 0u;
#pragma unroll
        for (unsigned j = 0; j < 16; ++j) { const unsigned c = xb_ld(&bar[XB_XCNT(j)]); sum += c; cnt += (c > 0u) ? 1u : 0u; mine = (j == x) ? c : mine; }
        if (sum == G) break;
        __builtin_amdgcn_s_sleep(1);
        if ((++sp & 255u) == 0u) { if (xb_ld(&bar[XB_TMO])) break; if (sp > XB_SPIN_CAP) { atomicAdd(&bar[XB_TMO], 1u); break; } }
    }
    nloc = mine > 0u ? mine : 1u; nx = cnt > 0u ? cnt : 1u;
}
__device__ __forceinline__ void xcd_barrier(const XcdBarrier& b, const int tid) {
    asm volatile("s_waitcnt vmcnt(0)" ::: "memory");
    __syncthreads();
    if (tid == 0) {
        unsigned* bar = b.bar;
        __builtin_amdgcn_s_waitcnt(0);
        unsigned nloc = b.st[0], nx = b.st[1];
        if (nloc == 0u) { xcd_barrier_complete(bar, b.x, nloc, nx); b.st[0] = nloc; b.st[1] = nx; }
        const unsigned old = xb_add(&bar[XB_XSUB(b.x)], 1u);
        const unsigned gen = old / nloc;
        if (old + 1u == (gen + 1u) * nloc) {
            __builtin_amdgcn_fence(__ATOMIC_RELEASE, "agent");
            asm volatile("s_waitcnt vmcnt(0)" ::: "memory");
            const unsigned og = xb_add(&bar[XB_TOP], 1u);
            const unsigned tg = og / nx;
            if (og + 1u == (tg + 1u) * nx) xb_add(&bar[XB_TOPGEN], 1u);
            else XB_SPIN(xb_ld(&bar[XB_TOPGEN]) == tg, bar);
            __builtin_amdgcn_fence(__ATOMIC_ACQUIRE, "agent");
            xb_add(&bar[XB_XGEN(b.x)], 1u);
            asm volatile("s_waitcnt vmcnt(0)" ::: "memory");
        } else {
            XB_SPIN(xb_ld(&bar[XB_XGEN(b.x)]) == gen, bar);
            __builtin_amdgcn_fence(__ATOMIC_ACQUIRE, "agent");
            asm volatile("s_waitcnt vmcnt(0)" ::: "memory");
        }
    }
    __syncthreads();
}

struct Frame {
    LAS unsigned char* lds;
    int tid, lane, wave, vcu, G;
    const float *xP, *xS, *spool, *cK, *cV, *cLF, *lng, *lnb, *w1, *w3, *w2, *poolw, *pools, *win, *bfg, *wo;
    float* out;
    unsigned char* ws;
    unsigned* ctl;
};

__device__ __forceinline__ float wave_sum(float v) {
#pragma unroll
    for (int o = 1; o < 64; o <<= 1) v += __shfl_xor(v, o);
    return v;
}

__device__ __forceinline__ void p0_transpose_item(const float* W, int ldw, int Kd, bf16* WT, int k0, int n0, int drow0, LAS float* scr, int lane, int ktm_rows = 0) {
#pragma unroll 8
    for (int i = 0; i < 32; ++i) { const int kk = 2 * i + (lane >> 5); scr[kk * 33 + (lane & 31)] = W[(size_t)(k0 + kk) * ldw + n0 + (lane & 31)]; }
    LDS_WAIT(); asm volatile("" ::: "memory");
    const int c = lane & 7;
#pragma unroll
    for (int j = 0; j < 4; ++j) { const int n = (lane >> 3) + 8 * j; const LAS float* s = scr + (8 * c) * 33 + n;
        v4u o; o.x = pk2(s[0 * 33], s[1 * 33]); o.y = pk2(s[2 * 33], s[3 * 33]); o.z = pk2(s[4 * 33], s[5 * 33]); o.w = pk2(s[6 * 33], s[7 * 33]);
        if (ktm_rows) *(GAS v4u*)(WT + ((size_t)(k0 >> 6) * ktm_rows + drow0 + n) * 64 + 8 * c) = o;
        else *(GAS v4u*)(WT + (size_t)(drow0 + n) * Kd + k0 + 8 * c) = o; }
    LDS_WAIT(); asm volatile("" ::: "memory");
}
constexpr int FFN_ITEMS = 3 * 8192, FFN_ITEMS_UPSLOT = 14848;
__device__ __forceinline__ void convert_ffn_item(Frame& F, int f, int q, LAS float* scr) {
    if (q < 2 * 8192) { const int which = q >> 13, r = q & 8191; const int nblk = FF / 32, kb = r / nblk, nb = r % nblk, n0 = 32 * nb;
        const float* W = (which ? F.w3 : F.w1) + (size_t)f * D * FF;
        p0_transpose_item(W, FF, D, ((bf16*)(F.ws + WS_W13)) + (size_t)f * 2 * FF * D, 64 * kb, n0, 256 * (n0 >> 7) + (n0 & 127) + 128 * which, scr, F.lane); }
    else { const int r = q - 2 * 8192; const int nblk = D / 32, kb = r / nblk, nb = r % nblk;
        p0_transpose_item(F.w2 + (size_t)f * FF * D, D, FFP, ((bf16*)(F.ws + WS_W2T)) + (size_t)f * D * FFP, 64 * kb, 32 * nb, 32 * nb, scr, F.lane, D); }
}
constexpr int CONV_CH = 32;
__device__ __forceinline__ void convert_elastic(Frame& F, int f, bool drain, unsigned* done_word) {
    if (f >= 4) return;
    LAS float* scr = (LAS float*)(F.lds + RING_OFF + F.wave * 16384);
    LAS unsigned* tick = (LAS unsigned*)(F.lds + RING_OFF + 126976);
    unsigned* head = F.ctl + CW_CQ + 64 * f;
    if (F.tid == 0 && !drain) __hip_atomic_fetch_add(done_word, 1u, __ATOMIC_RELAXED, __HIP_MEMORY_SCOPE_AGENT);
    for (;;) {
        if (F.tid == 0) {
            unsigned h = 0xffffffffu;
            if (drain || __hip_atomic_load(done_word, __ATOMIC_RELAXED, __HIP_MEMORY_SCOPE_AGENT) < (unsigned)F.G) h = __hip_atomic_fetch_add(head, (unsigned)CONV_CH, __ATOMIC_RELAXED, __HIP_MEMORY_SCOPE_AGENT);
            *tick = h;
        }
        __syncthreads();
        const unsigned h = *tick;
        __syncthreads();
        if (h >= (unsigned)FFN_ITEMS) break;
        for (int q = (int)h + F.wave; q < (int)h + CONV_CH; q += NWAVES) convert_ffn_item(F, f, q, scr);
    }
}
__device__ __forceinline__ void p0_prologue(Frame& F) {
    LAS float* scr = (LAS float*)(F.lds + RING_OFF + F.wave * 16384);
    const int gw = F.vcu * NWAVES + F.wave, NGW = F.G * NWAVES;
    constexpr int I_IN = (D / 64) * (3 * D / 32);
    constexpr int I_WO = (D / 64) * (D / 32);
    constexpr int I_PL = 4 * (512 / 64) * (512 / 32);
    constexpr int NITEMS = FFN_ITEMS + I_IN + I_WO + I_PL;
    for (int it = gw; it < NITEMS; it += NGW) {
        int r = it;
        if (r < FFN_ITEMS) { convert_ffn_item(F, 0, r, scr); continue; }
        r -= FFN_ITEMS;
        if (r < I_IN) { const int nblk = 3 * D / 32, kb = r / nblk, nb = r % nblk;
            p0_transpose_item(F.win, WIN_LD, D, ((bf16*)(F.ws + WS_WIN)), 64 * kb, 32 * nb, 32 * nb, scr, F.lane); continue; }
        r -= I_IN;
        if (r < I_WO) { const int nblk = D / 32, kb = r / nblk, nb = r % nblk;
            p0_transpose_item(F.wo, D, D, ((bf16*)(F.ws + WS_WO)), 64 * kb, 32 * nb, 32 * nb, scr, F.lane); continue; }
        r -= I_WO;
        { const int g = r >> 7, q = r & 127, kb = q >> 4, nb = q & 15;
            p0_transpose_item(F.poolw + (size_t)g * 512 * 512, 512, 512, ((bf16*)(F.ws + WS_POOLT)), 64 * kb, 32 * nb, g * 512 + 32 * nb, scr, F.lane); }
    }
    for (int m = gw; m < M; m += NGW) {
        const float* xrow = (m < SEQ) ? F.xP + (size_t)m * D : F.xS + (size_t)(m - SEQ) * D;
        const GAS f32x4* xr = (const GAS f32x4*)xrow + F.lane;
        GAS u32x2* o8 = (GAS u32x2*)(((bf16*)(F.ws + WS_XBF)) + (size_t)m * D) + F.lane;
#pragma unroll
        for (int j = 0; j < 8; ++j) { const f32x4 v = xr[64 * j]; u32x2 w; w.x = pk2(v.x, v.y); w.y = pk2(v.z, v.w); o8[64 * j] = w;
            if (m >= SEQ) ((GAS f32x4*)(((float*)(F.ws + WS_ZS)) + (size_t)(m - SEQ) * D))[F.lane + 64 * j] = v * ALPHA; }
    }
}

__device__ __forceinline__ float bfly16(float (&p)[16], int lane) {
    float q8[8], q4[4], q2[2];
    { const bool up = (lane & 32) != 0;
#pragma unroll
      for (int i = 0; i < 8; ++i) { const float keep = up ? p[i + 8] : p[i], send = up ? p[i] : p[i + 8]; q8[i] = keep + __shfl_xor(send, 32); } }
    { const bool up = (lane & 16) != 0;
#pragma unroll
      for (int i = 0; i < 4; ++i) { const float keep = up ? q8[i + 4] : q8[i], send = up ? q8[i] : q8[i + 4]; q4[i] = keep + __shfl_xor(send, 16); } }
    { const bool up = (lane & 8) != 0;
#pragma unroll
      for (int i = 0; i < 2; ++i) { const float keep = up ? q4[i + 2] : q4[i], send = up ? q4[i] : q4[i + 2]; q2[i] = keep + __shfl_xor(send, 8); } }
    float r;
    { const bool up = (lane & 4) != 0; const float keep = up ? q2[1] : q2[0], send = up ? q2[0] : q2[1]; r = keep + __shfl_xor(send, 4); }
    r += __shfl_xor(r, 2); r += __shfl_xor(r, 1);
    return r;
}
__device__ __forceinline__ void logf_rows(Frame& F, const LAS float* wft, const f32x4 (&va)[8], int rowa, const f32x4 (&vb)[8], int rowb, int lane) {
    float pa[16], pb[16];
#pragma unroll
    for (int h = 0; h < NH; ++h) {
        float xa = 0.f, xb = 0.f;
#pragma unroll
        for (int j = 0; j < 8; ++j) { const f32x4 w = *(const LAS f32x4*)(wft + h * D + 4 * lane + 256 * j);
            xa += (va[j].x * w.x + va[j].y * w.y) + (va[j].z * w.z + va[j].w * w.w); xb += (vb[j].x * w.x + vb[j].y * w.y) + (vb[j].z * w.z + vb[j].w * w.w); }
        pa[h] = xa; pb[h] = xb;
        __builtin_amdgcn_sched_barrier(0);
    }
    const float ma = bfly16(pa, lane), mb = bfly16(pb, lane);
    if ((lane & 3) == 0) {
        const int h = 8 * ((lane >> 5) & 1) + 4 * ((lane >> 4) & 1) + 2 * ((lane >> 3) & 1) + ((lane >> 2) & 1);
        const float bf = F.bfg[h];
        { const float z = ma + bf; const float lf = (z >= 0.f) ? -log1pf(expf(-z)) : (z - log1pf(expf(z)));
          float* lp = (rowa < SEQ) ? F.out + O_LP + (size_t)rowa * NH : F.out + O_LS + (size_t)(rowa - SEQ) * NH; lp[h] = lf; }
        { const float z = mb + bf; const float lf = (z >= 0.f) ? -log1pf(expf(-z)) : (z - log1pf(expf(z)));
          float* lp = (rowb < SEQ) ? F.out + O_LP + (size_t)rowb * NH : F.out + O_LS + (size_t)(rowb - SEQ) * NH; lp[h] = lf; }
    }
}
template <bool WBF, bool WPOOL, bool LOGF, bool FINAL, int NSL = 0>
__device__ __forceinline__ void ln_pass(Frame& F, const float* g, const float* b) {
    const int gw = F.vcu * NWAVES + F.wave, NGW = F.G * NWAVES, lane = F.lane;
    LAS float* wft = (LAS float*)(F.lds + RING_OFF);
    if (LOGF) {
        for (int idx = F.tid; idx < D * NH; idx += NWAVES * 64) { const int c = idx >> 4, h = idx & 15; wft[h * D + c] = F.win[(size_t)c * WIN_LD + 3 * D + h]; }
        __syncthreads();
    }
    f32x4 gv[8], bv[8];
#pragma unroll
    for (int j = 0; j < 8; ++j) { gv[j] = ((const GAS f32x4*)g)[lane + 64 * j]; bv[j] = ((const GAS f32x4*)b)[lane + 64 * j]; }
    f32x4 vp[8]; int pend = -1;
    constexpr int LNA = (NSL >= 8) ? 2 : (NSL >= 4) ? 4 : (NSL >= 2) ? 5 : 6;
    const bool heavy = gw < NS; const int nlight = NGW - NS;
    for (int it = 0;; ++it) {
        int row;
        if (heavy) { if (it > LNA) break; row = (it == 0) ? SEQ + gw : gw + NS * (it - 1); }
        else { row = NS * LNA + (gw - NS) + nlight * it; if (row >= SEQ) break; }
        float* srow = ((float*)(F.ws + WS_S)) + (size_t)row * D;
        const float* zrow = (row < SEQ) ? srow : ((float*)(F.ws + WS_ZS)) + (size_t)(row - SEQ) * D;
        f32x4 v[8]; float s = 0.f;
        if (row >= SEQ) {
#pragma unroll
            for (int j = 0; j < 8; ++j) v[j] = ((const GAS f32x4*)zrow)[lane + 64 * j];
        }
        if (row < SEQ) {
            const GAS u32x2* zb = (const GAS u32x2*)(((const bf16*)(F.ws + WS_S)) + (size_t)row * D);
#pragma unroll
            for (int j = 0; j < 8; ++j) { const u32x2 w = zb[lane + 64 * j]; v[j] = (f32x4){bf_lo(w.x), bf_hi(w.x), bf_lo(w.y), bf_hi(w.y)}; }
        }
        if (NSL > 0 && row >= SEQ) {
#pragma unroll
            for (int k = 0; k < NSL; ++k) { const GAS u32x2* sp = (const GAS u32x2*)(((bf16*)(F.ws + WS_SLAB)) + ((size_t)k * NS + (row - SEQ)) * D);
#pragma unroll
                for (int j = 0; j < 8; ++j) { const u32x2 w = sp[lane + 64 * j]; v[j] = v[j] + (f32x4){bf_lo(w.x), bf_hi(w.x), bf_lo(w.y), bf_hi(w.y)}; } }
        }
#pragma unroll
        for (int j = 0; j < 8; ++j) s += (v[j].x + v[j].y) + (v[j].z + v[j].w);
        const float mean = wave_sum(s) * (1.f / D); float s2 = 0.f;
#pragma unroll
        for (int j = 0; j < 8; ++j) { v[j] = v[j] - mean; s2 += (v[j].x * v[j].x + v[j].y * v[j].y) + (v[j].z * v[j].z + v[j].w * v[j].w); }
        const float rstd = 1.f / sqrtf(wave_sum(s2) * (1.f / D) + LN_EPS);
#pragma unroll
        for (int j = 0; j < 8; ++j) v[j] = v[j] * rstd * gv[j] + bv[j];
#ifdef PROBE_MASK_A
        if (FINAL && blockIdx.x == 0) {
            unsigned ta = 0, tb = 0;
            for (int k = 0; k < 20; ++k) { const unsigned dt = F.ctl[16384 + k + 1] - F.ctl[16384 + k]; if ((PROBE_MASK_A >> k) & 1) ta += dt; if ((PROBE_MASK_B >> k) & 1) tb += dt; }
            { const unsigned d1 = F.ctl[16384 + 21] - F.ctl[16384 + 15], d2 = F.ctl[16384 + 16] - F.ctl[16384 + 21];
              if ((PROBE_MASK_A >> 20) & 1) ta += d1; if ((PROBE_MASK_B >> 20) & 1) tb += d1; if ((PROBE_MASK_A >> 21) & 1) ta += d2; if ((PROBE_MASK_B >> 21) & 1) tb += d2; }
            { const unsigned t14 = F.ctl[16384 + 14]; const unsigned x0 = F.ctl[16384 + 50] - t14, x1 = F.ctl[16384 + 51] - F.ctl[16384 + 50], x2 = F.ctl[16384 + 52] - F.ctl[16384 + 51], y0 = F.ctl[16384 + 53] - t14, y1 = F.ctl[16384 + 54] - F.ctl[16384 + 53];
              const unsigned xs[5] = {x0, x1, x2, y0, y1};
              for (int k = 0; k < 5; ++k) { if ((PROBE_MASK_A >> (24 + k)) & 1) ta += xs[k]; if ((PROBE_MASK_B >> (24 + k)) & 1) tb += xs[k]; } }
            const float eps = (float)ta * 0.01f / (float)PROBE_TA, del = rintf((float)tb * 0.01f / (float)PROBE_TB);
            if (row >= SEQ) {
#pragma unroll
                for (int j = 0; j < 8; ++j) v[j] = v[j] + eps;
            }
            if (row == 0 && lane == 0) v[0].x += del;
        }
#endif
        if (FINAL) {
            float* orow = (row < SEQ) ? F.out + O_YP + (size_t)row * D : F.out + O_YS + (size_t)(row - SEQ) * D;
#pragma unroll
            for (int j = 0; j < 8; ++j) ((GAS f32x4*)orow)[lane + 64 * j] = v[j];
        } else if (row >= SEQ) {
#pragma unroll
            for (int j = 0; j < 8; ++j) ((GAS f32x4*)srow)[lane + 64 * j] = v[j];
#pragma unroll
            for (int j = 0; j < 8; ++j) ((GAS f32x4*)(((float*)(F.ws + WS_ZS)) + (size_t)(row - SEQ) * D))[lane + 64 * j] = v[j] * ALPHA;
        } else if (lane == 0) {
            *(GAS f32x2*)(((float*)(F.ws + WS_ST)) + 2 * (size_t)row) = (f32x2){mean, rstd};
        }
        if (WBF) {
            GAS u32x2* o8 = (GAS u32x2*)(((bf16*)(F.ws + WS_XBF)) + (size_t)row * D) + lane;
#pragma unroll
            for (int j = 0; j < 8; ++j) { u32x2 w; w.x = pk2(v[j].x, v[j].y); w.y = pk2(v[j].z, v[j].w); o8[64 * j] = w; }
        }
        if (WPOOL) {
            float* prow = nullptr;
            if (row >= SEQ - PST && row < SEQ) prow = F.out + O_PP + (size_t)(row - (SEQ - PST)) * D;
            else if (row >= SEQ) { const int bb = (row - SEQ) >> 4, i = (row - SEQ) & 15; if (i >= 1) prow = F.out + O_PS + ((size_t)bb * PST + (i - 1)) * D; }
            if (prow) {
#pragma unroll
                for (int j = 0; j < 8; ++j) ((GAS f32x4*)prow)[lane + 64 * j] = v[j];
            }
        }
        if (LOGF) {
            if (pend < 0) { pend = row;
#pragma unroll
                for (int j = 0; j < 8; ++j) vp[j] = v[j]; }
            else { logf_rows(F, wft, vp, pend, v, row, lane); pend = -1; }
        }
    }
    if (LOGF && pend >= 0) logf_rows(F, wft, vp, pend, vp, pend, lane);
    if (LOGF) __syncthreads();
}

template <int KIND>
__device__ __forceinline__ f32x4 pool_fetch(Frame& F, int b, int idx, int c4, const f32x4 g4, const f32x4 b4) {
    if (KIND == 0) { const bool ok = idx >= 0; const int r = ok ? idx : 0; const f32x2 ms = *(const GAS f32x2*)(((float*)(F.ws + WS_ST)) + 2 * (size_t)r);
        const u32x2 w = *(const GAS u32x2*)(((const bf16*)(F.ws + WS_S)) + (size_t)r * D + c4); const f32x4 x = ((f32x4){bf_lo(w.x), bf_hi(w.x), bf_lo(w.y), bf_hi(w.y)} - ms.x) * ms.y * g4 + b4;
        return ok ? x : (f32x4){0.f, 0.f, 0.f, 0.f}; }
    const float* p = (idx < PST) ? F.spool + ((size_t)b * PST + idx) * D : ((float*)(F.ws + WS_S)) + (size_t)(SEQ + b * DECT + idx - PST) * D;
    return *(const GAS f32x4*)(p + c4);
}
template <int W, int KIND>
__device__ __forceinline__ void pool_run(Frame& F, int b, int i0, int orow0, int c4, const f32x4 g4, const f32x4 b4) {
    f32x4 xs[W - 1 + 16];
#pragma unroll
    for (int k = 0; k < W - 1 + 16; ++k) xs[k] = pool_fetch<KIND>(F, b, i0 - (W - 1) + k, c4, g4, b4);
    f32x4 acc = (f32x4){0.f, 0.f, 0.f, 0.f};
#pragma unroll
    for (int k = 0; k < W - 1; ++k) acc = acc + xs[k];
#pragma unroll
    for (int e = 0; e < 16; ++e) {
        const int i = i0 + e;
        const f32x4 x = xs[W - 1 + e];
        acc = acc + x;
        const int cnti = (KIND == 0) ? ((i + 1 < W) ? i + 1 : W) : W;
        const float cnt = (float)cnti;
        const f32x4 d = acc / cnt - x;
        u32x2 o; o.x = pk2(d.x, d.y); o.y = pk2(d.z, d.w);
        *(GAS u32x2*)(((bf16*)(F.ws + WS_DB)) + (size_t)(orow0 + e) * D + c4) = o;
        acc = acc - xs[e];
    }
}
template <int KIND> __device__ __forceinline__ void pool_run_w(Frame& F, int grp, int b, int i0, int orow0, int c4, const f32x4 g4, const f32x4 b4) {
    if (grp == 0) pool_run<2, KIND>(F, b, i0, orow0, c4, g4, b4);
    else if (grp == 1) pool_run<4, KIND>(F, b, i0, orow0, c4, g4, b4);
    else if (grp == 2) pool_run<8, KIND>(F, b, i0, orow0, c4, g4, b4);
    else pool_run<16, KIND>(F, b, i0, orow0, c4, g4, b4);
}
__device__ __forceinline__ void pool_pass(Frame& F) {
    const int c4 = 4 * F.tid, grp = __builtin_amdgcn_readfirstlane(F.tid >> 7);
    const f32x4 g4 = *(const GAS f32x4*)(F.lng + c4), b4 = *(const GAS f32x4*)(F.lnb + c4);
    constexpr int NRUN_P = SEQ / 16, NRUN = NRUN_P + DECB;
    for (int run = F.vcu; run < NRUN; run += F.G) {
        if (run < NRUN_P) pool_run_w<0>(F, grp, 0, run * 16, run * 16, c4, g4, b4);
        else { const int b = run - NRUN_P; pool_run_w<1>(F, grp, b, PST, SEQ + b * DECT, c4, g4, b4); }
    }
}

__device__ __forceinline__ float block_excl_scan(float v, LAS float* buf, int tid) {
    const int lane = tid & 63, wv = tid >> 6;
    float x = v;
#pragma unroll
    for (int off = 1; off < 64; off <<= 1) { const float y = __shfl_up(x, off); if (lane >= off) x += y; }
    if (lane == 63) buf[wv] = x;
    __syncthreads();
    float base = 0.f;
#pragma unroll
    for (int k = 0; k < NWAVES; ++k) { const float t = buf[k]; if (k < wv) base += t; }
    __syncthreads();
    return base + x - v;
}

__device__ __forceinline__ void cl_scan(Frame& F, const int h) {
    const float* lf = F.out + O_LP;
    LAS float* buf = (LAS float*)(F.lds + RING_OFF);
    const int t0 = 32 * F.tid; float tot = 0.f;
#pragma unroll 8
    for (int e = 0; e < 32; ++e) tot += lf[(size_t)(t0 + e) * NH + h];
    float run = block_excl_scan(tot, buf, F.tid);
#pragma unroll 8
    for (int e = 0; e < 32; ++e) { run += lf[(size_t)(t0 + e) * NH + h]; ((float*)(F.ws + WS_CL))[(size_t)h * SEQ + t0 + e] = run * LOG2E; }
    __syncthreads();
}
__device__ __forceinline__ void kmax_pass(Frame& F, const int rank, const int nrank) {
    const int gw = rank * NWAVES + F.wave, NGW = nrank * NWAVES;
    float rmax[4] = {0.f, 0.f, 0.f, 0.f};
    for (int row = gw; row < SEQ; row += 4 * NGW) {
        u32x4 v[4][4];
#pragma unroll
        for (int r = 0; r < 4; ++r) { const int rr = (row + r * NGW < SEQ) ? row + r * NGW : row; const GAS u32x4* kp = (const GAS u32x4*)(((bf16*)(F.ws + WS_KB)) + (size_t)rr * D) + F.lane;
#pragma unroll
            for (int j = 0; j < 4; ++j) v[r][j] = kp[64 * j]; }
#pragma unroll
        for (int r = 0; r < 4; ++r)
#pragma unroll
            for (int j = 0; j < 4; ++j) { const u32x4 x = v[r][j]; float s = 0.f;
                s += bf_lo(x.x) * bf_lo(x.x) + bf_hi(x.x) * bf_hi(x.x); s += bf_lo(x.y) * bf_lo(x.y) + bf_hi(x.y) * bf_hi(x.y);
                s += bf_lo(x.z) * bf_lo(x.z) + bf_hi(x.z) * bf_hi(x.z); s += bf_lo(x.w) * bf_lo(x.w) + bf_hi(x.w) * bf_hi(x.w);
                s += __shfl_xor(s, 1); s += __shfl_xor(s, 2); s += __shfl_xor(s, 4); s += __shfl_xor(s, 8);
                rmax[j] = fmaxf(rmax[j], s); }
    }
    if ((F.lane & 15) == 0) {
#pragma unroll
        for (int j = 0; j < 4; ++j) atomicMax(F.ctl + CW_KMAX + (F.lane >> 4) + 4 * j, __float_as_uint(rmax[j]));
    }
}
__device__ __forceinline__ void vt_queue(Frame& F) {
    LAS unsigned* T = (LAS unsigned*)(F.lds + RING_OFF);
    constexpr int NIT = NH * (SEQ / 64), TSZ = 64 * 65;
    LAS unsigned* tick = T + 4 * TSZ;
    for (;;) {
        if (F.tid == 0) *tick = __hip_atomic_fetch_add(F.ctl + CW_VTQ, 4u, __ATOMIC_RELAXED, __HIP_MEMORY_SCOPE_AGENT);
        __syncthreads();
        const int it0 = (int)*tick;
        if (it0 >= NIT) break;
        u32x4 v[4][2];
#pragma unroll
        for (int r = 0; r < 4; ++r) { const int it = it0 + r; const int h = it & 15, s0 = (it >> 4) * 64;
#pragma unroll
            for (int i = 0; i < 2; ++i) { const int cidx = F.tid + 512 * i, s = cidx >> 4, dc = cidx & 15;
                v[r][i] = *(const GAS u32x4*)(((bf16*)(F.ws + WS_VB)) + (size_t)(s0 + s) * D + h * DH + 8 * dc); } }
#pragma unroll
        for (int r = 0; r < 4; ++r)
#pragma unroll
            for (int i = 0; i < 2; ++i) { const int cidx = F.tid + 512 * i, s = cidx >> 4, dc = cidx & 15;
                LAS unsigned* p = T + r * TSZ + s * 65 + 4 * dc; p[0] = v[r][i].x; p[1] = v[r][i].y; p[2] = v[r][i].z; p[3] = v[r][i].w; }
        __syncthreads();
#pragma unroll
        for (int r = 0; r < 4; ++r) { const int it = it0 + r; const int h = it & 15, s0 = (it >> 4) * 64;
#pragma unroll
            for (int i = 0; i < 2; ++i) { const int cidx = F.tid + 512 * i, d = cidx >> 3, sc = cidx & 7;
                const LAS unsigned short* ps = (const LAS unsigned short*)(T + r * TSZ) + d;
                unsigned e[8];
#pragma unroll
                for (int j = 0; j < 8; ++j) e[j] = ps[(size_t)(8 * sc + j) * 130];
                u32x4 o; o.x = e[0] | (e[1] << 16); o.y = e[2] | (e[3] << 16); o.z = e[4] | (e[5] << 16); o.w = e[6] | (e[7] << 16);
                *(GAS u32x4*)(((bf16*)(F.ws + WS_VT)) + (((size_t)h * (SEQ / 64) + (s0 >> 6)) * DH + d) * 64 + 8 * sc) = o; } }
        __syncthreads();
    }
}

#define MFMA32(a, b, c) __builtin_amdgcn_mfma_f32_32x32x16_bf16((a), (b), (c), 0, 0, 0)
__device__ __forceinline__ int kswz(int row, int colB) { return row * 256 + (colB ^ ((row & 7) << 4)); }
constexpr int AT_K = 0, AT_V = 32768, AT_C = 65536;

__device__ __forceinline__ void attn_prompt_unit(Frame& F, int h, int qb) {
    LAS unsigned char* lds = F.lds + RING_OFF;
    const int tid = F.tid, w = F.wave, lane = F.lane, c = lane & 31, hh = lane >> 5;
    const int q0 = 256 * qb + 32 * w, qrow = q0 + c;
    bf16x8 qf[8];
    { const bf16* Qp = ((bf16*)(F.ws + WS_QB)) + (size_t)qrow * D + h * DH + 8 * hh;
#pragma unroll
      for (int ch = 0; ch < 8; ++ch) qf[ch] = *(const GAS bf16x8*)(Qp + 16 * ch); }
    const float cq = ((float*)(F.ws + WS_CL))[(size_t)h * SEQ + qrow];
    f32x16 o[4];
#pragma unroll
    for (int db = 0; db < 4; ++db)
#pragma unroll
        for (int i = 0; i < 16; ++i) o[db][i] = 0.f;
    float m = -1e30f, lsum = 0.f;
    const int ntiles = 4 * qb + 4, tmax = 4 * qb + (w >> 1);
    float bnd;
    { float qn2 = 0.f;
#pragma unroll
      for (int ch = 0; ch < 8; ++ch) { const u32x4 qq = __builtin_bit_cast(u32x4, qf[ch]);
          qn2 += bf_lo(qq.x) * bf_lo(qq.x) + bf_hi(qq.x) * bf_hi(qq.x); qn2 += bf_lo(qq.y) * bf_lo(qq.y) + bf_hi(qq.y) * bf_hi(qq.y);
          qn2 += bf_lo(qq.z) * bf_lo(qq.z) + bf_hi(qq.z) * bf_hi(qq.z); qn2 += bf_lo(qq.w) * bf_lo(qq.w) + bf_hi(qq.w) * bf_hi(qq.w); }
      qn2 += __shfl_xor(qn2, 32);
      const float kmax2 = *(const LAS float*)(lds + AT_C + 1024 + 4 * h);
      bnd = sqrtf(qn2 * kmax2) * 1.001f + SKIP_THR; }
    bool done = false;
    LAS unsigned* flags = (LAS unsigned*)(lds + AT_C + 512);
    const int kr0 = tid >> 4, kc = tid & 15;
    const int vd0 = tid >> 3, vc = tid & 7;
    const unsigned char* wsb = (const unsigned char*)((float*)(F.ws + WS_S)) - WS_S;
    const unsigned koff = (unsigned)WS_KB + (unsigned)((kr0 * D + h * DH + 8 * kc) * 2);
    const unsigned voff = (unsigned)WS_VT + (unsigned)(((h * (SEQ / 64)) * DH + vd0) * 64 + 8 * vc) * 2u;
    const unsigned coff = (unsigned)WS_CL + (unsigned)((h * SEQ + (tid & 63)) * 4);
    u32x4 kst[2], vst[2]; float cst = 0.f;
#define AT_LOADK(kt) do { const unsigned _k0 = 64u * (unsigned)(kt); \
        kst[0] = *(const GAS u32x4*)(wsb + (koff + _k0 * (D * 2))); kst[1] = *(const GAS u32x4*)(wsb + (koff + _k0 * (D * 2) + 32 * D * 2)); \
        if (tid < 64) cst = *(const GAS float*)(wsb + (coff + _k0 * 4)); } while (0)
#define AT_LOADV(kt) do { const unsigned _k0 = 64u * (unsigned)(kt); \
        vst[0] = *(const GAS u32x4*)(wsb + (voff + _k0 * (DH * 2))); vst[1] = *(const GAS u32x4*)(wsb + (voff + _k0 * (DH * 2) + 64 * 64 * 2)); } while (0)
#define AT_WRITEK(buf) do { LAS unsigned char* _kb = lds + AT_K + (buf) * 16384; \
        *(LAS u32x4*)(_kb + kswz(kr0, 16 * kc)) = kst[0]; *(LAS u32x4*)(_kb + kswz(kr0 + 32, 16 * kc)) = kst[1]; \
        if (tid < 64) *(LAS float*)(lds + AT_C + (buf) * 256 + tid * 4) = cst; } while (0)
#define AT_WRITEV(buf) do { LAS unsigned char* _vb = lds + AT_V + (buf) * 16384; \
        { const int _f = (vd0 >> 1) & 15; LAS unsigned char* _r = _vb + vd0 * 128; \
          *(LAS u32x2*)(_r + (((2 * vc) ^ _f) << 3)) = (u32x2){vst[0].x, vst[0].y}; *(LAS u32x2*)(_r + (((2 * vc + 1) ^ _f) << 3)) = (u32x2){vst[0].z, vst[0].w}; } \
        { const int _d = vd0 + 64, _f = (_d >> 1) & 15; LAS unsigned char* _r = _vb + _d * 128; \
          *(LAS u32x2*)(_r + (((2 * vc) ^ _f) << 3)) = (u32x2){vst[1].x, vst[1].y}; *(LAS u32x2*)(_r + (((2 * vc + 1) ^ _f) << 3)) = (u32x2){vst[1].z, vst[1].w}; } } while (0)
    AT_LOADK(ntiles - 1); AT_LOADV(ntiles - 1); AT_WRITEK(0); AT_WRITEV(0); __syncthreads();
    int it = 0;
    for (int kt = ntiles - 1; kt >= 0; --kt, ++it) {
        const int buf = it & 1;
        const bool active = !done && kt <= tmax;
        f32x16 s0, s1;
        if (kt > 0) AT_LOADK(kt - 1);
        __builtin_amdgcn_sched_barrier(0);
        if (active) {
            const LAS unsigned char* Kb = lds + AT_K + buf * 16384;
#pragma unroll
            for (int i = 0; i < 16; ++i) { s0[i] = 0.f; s1[i] = 0.f; }
            const LAS unsigned char* Kr = Kb + c * 256;
            const int kx = (c & 7) << 4;
#pragma unroll
            for (int ch = 0; ch < 8; ++ch) {
                const int co = ((32 * (ch & 3) + 16 * hh) ^ kx) + 128 * (ch >> 2);
                const bf16x8 k0 = *(const LAS bf16x8*)(Kr + co);
                const bf16x8 k1 = *(const LAS bf16x8*)(Kr + co + 8192);
                s0 = MFMA32(k0, qf[ch], s0); s1 = MFMA32(k1, qf[ch], s1);
                __builtin_amdgcn_sched_barrier(0);
            }
        }
        __builtin_amdgcn_sched_barrier(0);
        if (kt > 0) { AT_WRITEK(buf ^ 1); AT_LOADV(kt - 1); }
        __builtin_amdgcn_sched_barrier(0);
        if (active) {
            const LAS unsigned char* Vb = lds + AT_V + buf * 16384; const LAS unsigned char* Cb = lds + AT_C + buf * 256;
#pragma unroll
            for (int g = 0; g < 4; ++g) {
                const f32x4 cb0 = *(const LAS f32x4*)(Cb + (8 * g + 4 * hh) * 4), cb1 = *(const LAS f32x4*)(Cb + (32 + 8 * g + 4 * hh) * 4);
#pragma unroll
                for (int e = 0; e < 4; ++e) { s0[4 * g + e] += cq - cb0[e]; s1[4 * g + e] += cq - cb1[e]; }
            }
            if (64 * kt + 63 > q0) {
#pragma unroll
                for (int i = 0; i < 16; ++i) { const int key = 64 * kt + (i & 3) + 8 * (i >> 2) + 4 * hh;
                    if (key > qrow) s0[i] = -INFINITY; if (key + 32 > qrow) s1[i] = -INFINITY; }
            }
            float mx = s0[0];
#pragma unroll
            for (int i = 1; i < 16; ++i) mx = fmaxf(mx, s0[i]);
#pragma unroll
            for (int i = 0; i < 16; ++i) mx = fmaxf(mx, s1[i]);
            mx = fmaxf(mx, __shfl_xor(mx, 32));
            const float mnew = fmaxf(m, mx), alpha = __builtin_amdgcn_exp2f(m - mnew); m = mnew;
            float ps = 0.f;
#pragma unroll
            for (int i = 0; i < 16; ++i) { s0[i] = __builtin_amdgcn_exp2f(s0[i] - mnew); s1[i] = __builtin_amdgcn_exp2f(s1[i] - mnew); ps += s0[i] + s1[i]; }
            lsum = lsum * alpha + ps;
            if (!__all(alpha == 1.0f)) {
#pragma unroll
                for (int db = 0; db < 4; ++db)
#pragma unroll
                    for (int i = 0; i < 16; ++i) o[db][i] *= alpha;
            }
            bf16x8 pf[2][2];
#pragma unroll
            for (int s2 = 0; s2 < 2; ++s2) {
                u32x4 a, b;
                a.x = cvtpk(s0[8 * s2 + 0], s0[8 * s2 + 1]); a.y = cvtpk(s0[8 * s2 + 2], s0[8 * s2 + 3]); a.z = cvtpk(s0[8 * s2 + 4], s0[8 * s2 + 5]); a.w = cvtpk(s0[8 * s2 + 6], s0[8 * s2 + 7]);
                b.x = cvtpk(s1[8 * s2 + 0], s1[8 * s2 + 1]); b.y = cvtpk(s1[8 * s2 + 2], s1[8 * s2 + 3]); b.z = cvtpk(s1[8 * s2 + 4], s1[8 * s2 + 5]); b.w = cvtpk(s1[8 * s2 + 6], s1[8 * s2 + 7]);
                pf[0][s2] = __builtin_bit_cast(bf16x8, a); pf[1][s2] = __builtin_bit_cast(bf16x8, b);
            }
#pragma unroll
            for (int db = 0; db < 4; ++db) {
                const int f = (c >> 1) & 15; const LAS unsigned char* rowb = Vb + c * 128 + db * 4096;
#pragma unroll
                for (int kb = 0; kb < 2; ++kb)
#pragma unroll
                    for (int s2 = 0; s2 < 2; ++s2) {
                        const int g0 = 8 * kb + 4 * s2 + hh;
                        const u32x2 lo = *(const LAS u32x2*)(rowb + ((g0 ^ f) << 3)), hi = *(const LAS u32x2*)(rowb + (((g0 + 2) ^ f) << 3));
                        const u32x4 vv = (u32x4){lo.x, lo.y, hi.x, hi.y};
                        o[db] = MFMA32(__builtin_bit_cast(bf16x8, vv), pf[kb][s2], o[db]);
                    }
                __builtin_amdgcn_sched_barrier(0);
            }
            if (kt > 0) { const float edge = *(const GAS float*)(wsb + ((unsigned)WS_CL + (unsigned)((h * SEQ + 64 * kt - 1) * 4))); done = __all(bnd + (cq - edge) < m); }
        }
        __builtin_amdgcn_sched_barrier(0);
        if (lane == 0) flags[buf * 8 + w] = done ? 1u : 0u;
        if (kt > 0) AT_WRITEV(buf ^ 1);
        __syncthreads();
        { const u32x4 f0 = *(const LAS u32x4*)(flags + buf * 8), f1 = *(const LAS u32x4*)(flags + buf * 8 + 4);
          if ((f0.x & f0.y & f0.z & f0.w & f1.x & f1.y & f1.z & f1.w) != 0u) break; }
    }
#undef AT_LOADK
#undef AT_LOADV
#undef AT_WRITEK
#undef AT_WRITEV
    const float ltot = lsum + __shfl_xor(lsum, 32), inv = 1.0f / ltot;
    bf16* Op = ((bf16*)(F.ws + WS_OB)) + (size_t)qrow * D + h * DH;
#pragma unroll
    for (int db = 0; db < 4; ++db)
#pragma unroll
        for (int g = 0; g < 4; g += 2) {
            u32x2 a, b2;
            a.x = cvtpk(o[db][4 * g] * inv, o[db][4 * g + 1] * inv); a.y = cvtpk(o[db][4 * g + 2] * inv, o[db][4 * g + 3] * inv);
            b2.x = cvtpk(o[db][4 * g + 4] * inv, o[db][4 * g + 5] * inv); b2.y = cvtpk(o[db][4 * g + 6] * inv, o[db][4 * g + 7] * inv);
            { auto r0 = __builtin_amdgcn_permlane32_swap(a.x, b2.x, false, false); a.x = r0[0]; b2.x = r0[1]; }
            { auto r1 = __builtin_amdgcn_permlane32_swap(a.y, b2.y, false, false); a.y = r1[0]; b2.y = r1[1]; }
            u32x4 wv; wv.x = a.x; wv.y = a.y; wv.z = b2.x; wv.w = b2.y;
            *(GAS u32x4*)(Op + 32 * db + 8 * g + 8 * hh) = wv;
        }
}

constexpr bool SA_KTOUCH = false;
constexpr int SA_CS = 0;
constexpr int SA_SCAN = 8448;
constexpr int SA_P = 12800;
constexpr int SA_A = 29184;
constexpr int SA_M = 29696, SA_L = 30208;
constexpr int SA_O = 32768;
__device__ __forceinline__ void attn_sample_unit(Frame& F, int b, int h) {
    LAS unsigned char* lds = F.lds + RING_OFF;
    const int tid = F.tid, w = F.wave, lane = F.lane, c = lane & 31, hh = lane >> 5, qi = c & 15;
    LAS float* cs = (LAS float*)(lds + SA_CS);
    {
        const float* lf = F.cLF + ((size_t)b * PAST) * NH + h;
        float v[4], tot = 0.f;
#pragma unroll
        for (int e = 0; e < 4; ++e) { v[e] = lf[(size_t)(4 * tid + e) * NH]; tot += v[e]; }
        float run = block_excl_scan(tot, (LAS float*)(lds + SA_SCAN), tid);
#pragma unroll
        for (int e = 0; e < 4; ++e) { run += v[e]; cs[4 * tid + e] = run * LOG2E; }
        __syncthreads();
        if (tid < 64) { const float* ln = F.out + O_LS + (size_t)(b * DECT) * NH + h;
            float x = (lane < DECT) ? ln[(size_t)lane * NH] * LOG2E : 0.f;
#pragma unroll
            for (int off = 1; off < 16; off <<= 1) { const float y = __shfl_up(x, off); if (lane >= off) x += y; }
            const float tot = __shfl(x, DECT - 1);
            if (lane < 32) cs[PAST + lane] = cs[PAST - 1] + ((lane < DECT) ? x : tot); }
        __syncthreads();
    }
    bf16x8 qf[8];
    { const bf16* Qp = ((bf16*)(F.ws + WS_QB)) + (size_t)(SEQ + b * DECT + qi) * D + h * DH + 8 * hh;
#pragma unroll
      for (int ch = 0; ch < 8; ++ch) { bf16x8 t = *(const GAS bf16x8*)(Qp + 16 * ch); if (c >= 16) t = (bf16x8){0, 0, 0, 0, 0, 0, 0, 0}; qf[ch] = t; } }
    const float cq = cs[PAST + qi];
    float m = -1e30f, lsum = 0.f;
    float oa[16][2];
#pragma unroll
    for (int q = 0; q < 16; ++q) { oa[q][0] = 0.f; oa[q][1] = 0.f; }
    LAS float* Pw = (LAS float*)(lds + SA_P + w * 2048);
    LAS float* Aw = (LAS float*)(lds + SA_A + w * 64);
    float dummy = 0.f;
    const int trow = lane >> 1, tcol = (lane & 1) * 64;
    const char* cKb = (const char*)F.cK; const char* cVb = (const char*)F.cV;
    const unsigned tile_b = 32u * NH * DH * 4u;
    LAS unsigned char* Kst = lds + SA_O + w * 8192;
    LAS unsigned char* kwb[4];
#pragma unroll
    for (int jj = 0; jj < 4; ++jj) { const int key = 2 * jj + (lane >> 5); kwb[jj] = Kst + key * 256 + (((((lane & 31) >> 1) ^ (key & 7)) << 4) + 8 * (lane & 1)); }
    const unsigned toff = (unsigned)((((b * PAST + trow) * NH + h) * DH + tcol) * 4), kcoff = (unsigned)((((b * PAST + (lane >> 5)) * NH + h) * DH + 4 * (lane & 31)) * 4), voff = (unsigned)(((b * PAST * NH + h) * DH + 2 * lane) * 4);
#define SA_TOUCHK(T_, j0, j1) do { const unsigned _o = toff + (unsigned)(T_) * tile_b; j0 = *(const GAS float*)(cKb + _o); j1 = *(const GAS float*)(cKb + (_o + 128u)); } while (0)
    float tk0 = 0.f, tk1 = 0.f;
    if (SA_KTOUCH) { const int T0 = 64 - w; if (T0 < 64) SA_TOUCHK(T0, tk0, tk1); }
    for (int T = 64 - w; T >= 0; T -= NWAVES) {
        f32x16 s;
#pragma unroll
        for (int i = 0; i < 16; ++i) s[i] = 0.f;
        if (SA_KTOUCH) { dummy += tk0 + tk1;
            if (T >= NWAVES) SA_TOUCHK(T - NWAVES, tk0, tk1); }
        if (T < 64) {
            const char* kt = cKb + (size_t)T * tile_b;
            f32x4 kr[16];
#pragma unroll
            for (int j = 0; j < 16; ++j) kr[j] = *(const GAS f32x4*)((kt + (size_t)j * (2u * NH * DH * 4u)) + kcoff);
#pragma unroll
            for (int j = 0; j < 16; ++j) { u32x2 pk; pk.x = cvtpk(kr[j].x, kr[j].y); pk.y = cvtpk(kr[j].z, kr[j].w);
                *(LAS u32x2*)(kwb[j & 3] + (j >> 2) * 2048) = pk; }
            asm volatile("s_waitcnt lgkmcnt(0)" ::: "memory"); __builtin_amdgcn_wave_barrier();
#pragma unroll
            for (int ch = 0; ch < 8; ++ch) { const bf16x8 kk = *(const LAS bf16x8*)(Kst + c * 256 + (((2 * ch + hh) ^ (c & 7)) << 4));
                s = MFMA32(kk, qf[ch], s); }
        } else {
            const bf16* kp = ((bf16*)(F.ws + WS_KB)) + (size_t)(SEQ + b * DECT + qi) * D + h * DH + 8 * hh;
#pragma unroll
            for (int ch = 0; ch < 8; ++ch) { bf16x8 kk = *(const GAS bf16x8*)(kp + 16 * ch); if (c >= 16) kk = (bf16x8){0, 0, 0, 0, 0, 0, 0, 0};
                s = MFMA32(kk, qf[ch], s); }
        }
        { const LAS float* csb = cs + 32 * T + 4 * hh;
#pragma unroll
          for (int g = 0; g < 4; ++g) { const f32x4 cb = *(const LAS f32x4*)(csb + 8 * g);
#pragma unroll
            for (int e = 0; e < 4; ++e) s[4 * g + e] += cq - cb[e]; } }
        if (T == 64) {
#pragma unroll
            for (int i = 0; i < 16; ++i) { const int kl = (i & 3) + 8 * (i >> 2) + 4 * hh; if (kl > qi) s[i] = -INFINITY; }
        }
        float mx = s[0];
#pragma unroll
        for (int i = 1; i < 16; ++i) mx = fmaxf(mx, s[i]);
        mx = fmaxf(mx, __shfl_xor(mx, 32));
        if (__all((c >= 16) || (mx < m - SKIP_THR))) continue;
        float tv0 = 0.f, tv1 = 0.f;
        if (T < 64) { const unsigned _o = toff + (unsigned)T * tile_b; tv0 = *(const GAS float*)(cVb + _o); tv1 = *(const GAS float*)(cVb + (_o + 128u)); }
        const float mnew = fmaxf(m, mx), alpha = __builtin_amdgcn_exp2f(m - mnew); m = mnew;
        float ps = 0.f;
#pragma unroll
        for (int i = 0; i < 16; ++i) { s[i] = __builtin_amdgcn_exp2f(s[i] - mnew); ps += s[i]; }
        lsum = lsum * alpha + ps;
        if (c < 16) {
            LAS float* pb = Pw + 64 * hh + c;
#pragma unroll
            for (int i = 0; i < 16; ++i) pb[((i & 3) + 8 * (i >> 2)) * 16] = s[i];
            if (hh == 0) Aw[c] = alpha;
        }
        asm volatile("s_waitcnt lgkmcnt(0)" ::: "memory"); __builtin_amdgcn_wave_barrier();
        {
            f32x4 a4[4];
#pragma unroll
            for (int j = 0; j < 4; ++j) a4[j] = *(const LAS f32x4*)(Aw + 4 * j);
#pragma unroll
            for (int q = 0; q < 16; ++q) { oa[q][0] *= a4[q >> 2][q & 3]; oa[q][1] *= a4[q >> 2][q & 3]; }
        }
        dummy += tv0 + tv1;
        if (T < 64) {
            const char* vtb = cVb + (size_t)T * tile_b;
#pragma unroll 8
            for (int kl = 0; kl < 32; ++kl) {
                const f32x2 v2 = *(const GAS f32x2*)((vtb + (size_t)kl * (NH * DH * 4u)) + voff);
                f32x4 p4[4];
#pragma unroll
                for (int j = 0; j < 4; ++j) p4[j] = *(const LAS f32x4*)(Pw + kl * 16 + 4 * j);
#pragma unroll
                for (int q = 0; q < 16; ++q) { const float p = p4[q >> 2][q & 3]; oa[q][0] += p * v2.x; oa[q][1] += p * v2.y; }
            }
        } else {
            const bf16* vp = ((bf16*)(F.ws + WS_VB)) + (size_t)(SEQ + b * DECT) * D + h * DH + 2 * lane;
#pragma unroll 4
            for (int kl = 0; kl < 16; ++kl) {
                const unsigned vw = *(const GAS unsigned*)(vp + (size_t)kl * D);
                const float vx = bf_lo(vw), vy = bf_hi(vw);
                f32x4 p4[4];
#pragma unroll
                for (int j = 0; j < 4; ++j) p4[j] = *(const LAS f32x4*)(Pw + kl * 16 + 4 * j);
#pragma unroll
                for (int q = 0; q < 16; ++q) { const float p = p4[q >> 2][q & 3]; oa[q][0] += p * vx; oa[q][1] += p * vy; }
            }
        }
        asm volatile("s_waitcnt lgkmcnt(0)" ::: "memory"); __builtin_amdgcn_wave_barrier();
    }
#undef SA_TOUCHK
    if (dummy == 123.456f) Aw[0] = dummy;
    {
        const float ltot = lsum + __shfl_xor(lsum, 32);
        LAS float* Mb = (LAS float*)(lds + SA_M); LAS float* Lb = (LAS float*)(lds + SA_L); LAS float* Ob = (LAS float*)(lds + SA_O);
        if (lane < 16) { Mb[w * 16 + lane] = m; Lb[w * 16 + lane] = ltot; }
#pragma unroll
        for (int q = 0; q < 16; ++q) *(LAS f32x2*)(Ob + (w * 16 + q) * 128 + 2 * lane) = (f32x2){oa[q][0], oa[q][1]};
        __syncthreads();
        { const int q0 = tid >> 7, d = tid & 127;
          const LAS float* Mq = Mb + q0; const LAS float* Lq = Lb + q0; const LAS float* Oq = Ob + q0 * 128 + d;
#pragma unroll
          for (int i = 0; i < 4; ++i) {
            float mx = Mq[4 * i];
#pragma unroll
            for (int ww = 1; ww < 8; ++ww) mx = fmaxf(mx, Mq[ww * 16 + 4 * i]);
            float L = 0.f, ov = 0.f;
#pragma unroll
            for (int ww = 0; ww < 8; ++ww) { const float sc = __builtin_amdgcn_exp2f(Mq[ww * 16 + 4 * i] - mx); L += Lq[ww * 16 + 4 * i] * sc; ov += Oq[(ww * 16 + 4 * i) * 128] * sc; }
            ((bf16*)(F.ws + WS_OB))[(size_t)(SEQ + b * DECT + q0 + 4 * i) * D + h * DH + d] = (bf16)f2bf(ov / L);
          } }
        __syncthreads();
    }
}

constexpr int NPHASE = 21;
struct Args { const float* in[16]; float* out; unsigned char* ws; int ph_lo, ph_hi; };
__global__ void __launch_bounds__(NWAVES * 64, 2) trunk_fwd(Args args) {
    extern __shared__ __attribute__((aligned(16))) unsigned char lds[];
    Frame F;
    F.lds = (LAS unsigned char*)lds;
    const int wave_s = __builtin_amdgcn_readfirstlane((int)threadIdx.x >> 6);
#define REFRESH() do { unsigned _z = 0u; asm volatile("" : "+s"(_z)); const int _l = (int)__builtin_amdgcn_mbcnt_hi(~0u, __builtin_amdgcn_mbcnt_lo(~0u, _z)); F.lane = _l; F.wave = wave_s; F.tid = wave_s * 64 + _l; } while (0)
    REFRESH();
    F.G = gridDim.x; { const int bx = blockIdx.x; F.vcu = (F.G % 8 == 0) ? (bx % 8) * (F.G / 8) + bx / 8 : bx; }
    unsigned char* ws = args.ws;
    F.xP = args.in[0]; F.xS = args.in[1]; F.spool = args.in[2]; F.cK = args.in[3]; F.cV = args.in[4]; F.cLF = args.in[5]; F.lng = args.in[6]; F.lnb = args.in[7];
    F.w1 = args.in[8]; F.w3 = args.in[9]; F.w2 = args.in[10]; F.poolw = args.in[11]; F.pools = args.in[12]; F.win = args.in[13]; F.bfg = args.in[14]; F.wo = args.in[15];
    F.out = args.out; F.ctl = (unsigned*)(ws + WS_CTL);
    F.ws = ws;
    for (int u = F.tid; u < (LDS_BYTES - LDSCTL_OFF) / 4; u += NWAVES * 64) ((LAS unsigned*)(F.lds + LDSCTL_OFF))[u] = 0u;
    __syncthreads();
    volatile LAS unsigned* MISC = (volatile LAS unsigned*)(F.lds + MISC_OFF);
    XcdBarrier bar; bar.bar = (unsigned*)(ws + WS_CTL) + CW_BAR; bar.x = 0; bar.st = nullptr;
    if (!MK_SPLIT) bar = xcd_barrier_post((unsigned*)(ws + WS_CTL) + CW_BAR, MISC + 8, F.tid);
    const int lo = args.ph_lo, hi = args.ph_hi;
#ifdef ONLY_PHASE
#define IN(k) ((k) == ONLY_PHASE && lo <= (k) && (k) < hi)
#else
#define IN(k) (lo <= (k) && (k) < hi)
#endif
#ifdef PROBE_MASK_A
#define STAMP(k) do { if (blockIdx.x == 0) { if (F.tid == 0) { F.ctl[16384 + (k)] = (unsigned)__builtin_amdgcn_s_memrealtime(); asm volatile("s_waitcnt vmcnt(0)" ::: "memory"); } __syncthreads(); } } while (0)
#else
#define STAMP(k) do { } while (0)
#endif
#define SEAM(k) do { if (IN(k) && IN((k) + 1)) xcd_barrier(bar, F.tid); REFRESH(); STAMP((k) + 1); } while (0)
#define UP_PHASE(k, f) if (IN(k)) { pg8::Gemm g{((bf16*)(F.ws + WS_XBF)), ((bf16*)(F.ws + WS_W13)) + (size_t)(f) * 2 * FF * D, D, D, D, 128, 128}; pg8::StaticOrder S; S.init(M, 2 * FF, F.G, (int)blockIdx.x, D); S.dynL = 16 * F.G; S.dynw = F.ctl + CW_DY + 64 * (k); S.dynl = (LAS unsigned*)(F.lds + MISC_OFF + 64); \
        pg8::EpiSwiglu E{((bf16*)(F.ws + WS_HB))}; pg8::gemm_phase<pg8::EpiSwiglu, pg8::StaticOrder>(F.lds + RING_OFF, g, S, E, F.tid); convert_elastic(F, (f) + 1, false, F.ctl + CW_CD + 64 * (f)); } SEAM(k)
#define DOWN_PHASE(k, f, sp, ss, lni) if (IN(k)) { pg8::Gemm g{((bf16*)(F.ws + WS_HB)), ((bf16*)(F.ws + WS_W2T)) + (size_t)(f) * D * FFP, 64, 64, FF, (size_t)M * 128, (size_t)D * 128}; pg8::StaticOrder S; S.init(M, D, F.G, (int)blockIdx.x, FF, 0, 0, 8, 4); \
        pg8::EpiResid E{((float*)(F.ws + WS_S)), (sp), (ss), 0.5f, nullptr, ((float*)(F.ws + WS_ZS)), ((float*)(F.ws + WS_SLAB)), (lni) >= 0 ? ((float*)(F.ws + WS_ST)) : nullptr, F.lng + ((lni) >= 0 ? (lni) : 0) * D, F.lnb + ((lni) >= 0 ? (lni) : 0) * D, (lni) >= 0 ? nullptr : ((const bf16*)(F.ws + WS_XBF))}; pg8::gemm_phase<pg8::EpiResid, pg8::StaticOrder>(F.lds + RING_OFF, g, S, E, F.tid); if ((f) != 2) convert_elastic(F, (f) + 1, true, nullptr); } SEAM(k)

    STAMP(0);
    if (IN(0)) { p0_prologue(F); } SEAM(0);
    UP_PHASE(1, 0);
    DOWN_PHASE(2, 0, F.xP, F.xS, -1);
    if (IN(3)) { ln_pass<false, true, false, false, 8>(F, F.lng + 0 * D, F.lnb + 0 * D); } SEAM(3);
    if (IN(4)) { pool_pass(F); } SEAM(4);
    if (IN(5)) { pg8::Gemm g{((bf16*)(F.ws + WS_DB)), ((bf16*)(F.ws + WS_POOLT)), D, 512, 512, 128, 128}; pg8::StaticOrder S; S.init(M, D, F.G, (int)blockIdx.x, 512, 2, 512 * 2, 2);
        pg8::EpiResid E{((float*)(F.ws + WS_S)), ((float*)(F.ws + WS_S)), ((float*)(F.ws + WS_S)) + (size_t)SEQ * D, 1.0f, F.pools, ((float*)(F.ws + WS_ZS)), ((float*)(F.ws + WS_SLAB)), ((float*)(F.ws + WS_ST)), F.lng + 0 * D, F.lnb + 0 * D}; pg8::gemm_phase<pg8::EpiResid, pg8::StaticOrder>(F.lds + RING_OFF, g, S, E, F.tid); } SEAM(5);
    if (IN(6)) { ln_pass<true, false, false, false, 2>(F, F.lng + 1 * D, F.lnb + 1 * D); } SEAM(6);
    UP_PHASE(7, 1);
    DOWN_PHASE(8, 1, ((float*)(F.ws + WS_S)), ((float*)(F.ws + WS_S)) + (size_t)SEQ * D, 1);
    if (IN(9)) { ln_pass<true, false, false, false, 8>(F, F.lng + 2 * D, F.lnb + 2 * D); } SEAM(9);
    UP_PHASE(10, 2);
    DOWN_PHASE(11, 2, ((float*)(F.ws + WS_S)), ((float*)(F.ws + WS_S)) + (size_t)SEQ * D, 2);
    if (IN(12)) { ln_pass<true, false, true, false, 8>(F, F.lng + 3 * D, F.lnb + 3 * D); } SEAM(12);
    if (IN(13)) { pg8::Gemm g{((bf16*)(F.ws + WS_XBF)), ((bf16*)(F.ws + WS_WIN)), D, D, D, 128, 128}; pg8::StaticOrder S; S.init(M, 3 * D, F.G, (int)blockIdx.x, D);
        if (!((int)blockIdx.x >= 48 && (int)blockIdx.x < 48 + NH)) { S.dynw = F.ctl + CW_DY + 64 * 13; S.dynl = (LAS unsigned*)(F.lds + MISC_OFF + 64); } S.dynL = 6 * F.G;
        pg8::EpiQKV E{((bf16*)(F.ws + WS_QB)), (size_t)(WS_KB - WS_QB) / 2, F.out + O_KP, F.out + O_KS, ((bf16*)(F.ws + WS_VT)), F.ctl + CW_KMAX}; pg8::gemm_phase<pg8::EpiQKV, pg8::StaticOrder>(F.lds + RING_OFF, g, S, E, F.tid);
        if ((int)blockIdx.x >= 48 && (int)blockIdx.x < 48 + NH) cl_scan(F, (int)blockIdx.x - 48);
        convert_elastic(F, 3, true, nullptr);
    } SEAM(13);
    REFRESH();
    if (IN(15)) {
        {
            LAS unsigned* tick = (LAS unsigned*)(F.lds + RING_OFF + 126976);
#if !defined(ATT_ONLY) || ATT_ONLY == 2
            for (;;) {
                if (F.tid == 0) *tick = __hip_atomic_fetch_add(F.ctl + CW_Q2, 1u, __ATOMIC_RELAXED, __HIP_MEMORY_SCOPE_AGENT);
                __syncthreads();
                const int u = (int)*tick;
                __syncthreads();
                if (u >= DECB * NH) break;
                attn_sample_unit(F, u >> 4, u & 15);
            }
#endif
            STAMP(21);
            __syncthreads();
        {
            LAS float* kml = (LAS float*)(F.lds + RING_OFF + AT_C + 1024);
            const int hd = F.tid >> 5, l5 = F.tid & 31; const unsigned* kqh = F.ctl + CW_KMAX + (size_t)hd * 4 * 128;
            float bm = 0.f;
#pragma unroll
            for (int p4 = 0; p4 < 4; ++p4) { float bsum = 0.f;
#pragma unroll
                for (int qq = 0; qq < 4; ++qq) bsum += __uint_as_float(__hip_atomic_load(kqh + qq * 128 + l5 + 32 * p4, __ATOMIC_RELAXED, __HIP_MEMORY_SCOPE_AGENT));
                bm = fmaxf(bm, bsum); }
#pragma unroll
            for (int o = 1; o < 32; o <<= 1) bm = fmaxf(bm, __shfl_xor(bm, o));
            if (l5 == 0) kml[hd] = bm;
            __syncthreads();
        }
#if !defined(ATT_ONLY) || ATT_ONLY == 1
            for (;;) {
                if (F.tid == 0) *tick = __hip_atomic_fetch_add(F.ctl + CW_Q1, 1u, __ATOMIC_RELAXED, __HIP_MEMORY_SCOPE_AGENT);
                __syncthreads();
                const int u = (int)*tick;
                __syncthreads();
                if (u >= NH * 64) break;
                attn_prompt_unit(F, u & 15, 63 - (u >> 4));
            }
#endif
        }
    } SEAM(15);
    if (IN(16)) { pg8::Gemm g{((bf16*)(F.ws + WS_OB)), ((bf16*)(F.ws + WS_WO)), D, D, D, 128, 128}; pg8::StaticOrder S; S.init(M, D, F.G, (int)blockIdx.x, D, 0, 0, 4);
        pg8::EpiResid E{((float*)(F.ws + WS_S)), ((float*)(F.ws + WS_S)), ((float*)(F.ws + WS_S)) + (size_t)SEQ * D, 1.0f, nullptr, ((float*)(F.ws + WS_ZS)), ((float*)(F.ws + WS_SLAB)), ((float*)(F.ws + WS_ST)), F.lng + 3 * D, F.lnb + 3 * D}; pg8::gemm_phase<pg8::EpiResid, pg8::StaticOrder>(F.lds + RING_OFF, g, S, E, F.tid); } SEAM(16);
    if (IN(17)) { ln_pass<true, false, false, false, 4>(F, F.lng + 4 * D, F.lnb + 4 * D); } SEAM(17);
    UP_PHASE(18, 3);
    DOWN_PHASE(19, 3, ((float*)(F.ws + WS_S)), ((float*)(F.ws + WS_S)) + (size_t)SEQ * D, 4);
    if (IN(20)) { ln_pass<false, false, false, true, 8>(F, F.lng + 5 * D, F.lnb + 5 * D); }
#undef IN
#undef SEAM
#undef UP_PHASE
#undef DOWN_PHASE
}

extern "C" void kernel_launch(void* const* d_in, const int* in_sizes, int n_in, void* d_out, int out_size, void* d_ws, size_t ws_size, hipStream_t stream) {
    static int grid = 0;
    if (grid == 0) {
        if (n_in != 16 || (size_t)out_size != O_END || ws_size < WS_END) { fprintf(stderr, "kernel_launch: unexpected shapes (n_in %d, out %d, ws %zu)\n", n_in, out_size, ws_size); grid = -1; return; }
        int dev = 0, cus = 0, per_cu = 0;
        if (hipGetDevice(&dev) != hipSuccess || hipDeviceGetAttribute(&cus, hipDeviceAttributeMultiprocessorCount, dev) != hipSuccess) { grid = -1; return; }
        if (hipFuncSetAttribute((const void*)trunk_fwd, hipFuncAttributeMaxDynamicSharedMemorySize, LDS_BYTES) != hipSuccess) { fprintf(stderr, "kernel_launch: hipFuncSetAttribute failed\n"); grid = -1; return; }
        if (hipOccupancyMaxActiveBlocksPerMultiprocessor(&per_cu, (const void*)trunk_fwd, NWAVES * 64, LDS_BYTES) != hipSuccess || per_cu < 1)
            fprintf(stderr, "kernel_launch: occupancy query reports %d workgroups per CU\n", per_cu);
        (void)hipGetLastError();
        grid = cus;
    }
    if (grid < 0) return;
    (void)hipMemsetAsync((char*)d_ws + WS_CTL, 0, CTL_ZERO_BYTES, stream);
    Args a{};
    for (int i = 0; i < 16; ++i) a.in[i] = (const float*)d_in[i];
    a.out = (float*)d_out; a.ws = (unsigned char*)d_ws;
#if MK_SPLIT
    for (int k = 0; k < NPHASE; ++k) { a.ph_lo = k; a.ph_hi = k + 1; hipLaunchKernelGGL(trunk_fwd, dim3(grid), dim3(NWAVES * 64), LDS_BYTES, stream, a); }
#else
    a.ph_lo = 0; a.ph_hi = NPHASE; hipLaunchKernelGGL(trunk_fwd, dim3(grid), dim3(NWAVES * 64), LDS_BYTES, stream, a);
#endif
}
```

```cpp
#include <hip/hip_runtime.h>
#include <cstdio>
#include <cstdint>

#ifndef MK_SPLIT
#define MK_SPLIT 0
#endif

#define LAS __attribute__((address_space(3)))
#define GAS __attribute__((address_space(1)))
typedef unsigned short bf16;
typedef short bf16x8 __attribute__((ext_vector_type(8)));
typedef float f32x4 __attribute__((ext_vector_type(4)));
typedef float f32x2 __attribute__((ext_vector_type(2)));
typedef float f32x16 __attribute__((ext_vector_type(16)));
typedef unsigned u32x4 __attribute__((ext_vector_type(4)));
typedef unsigned u32x2 __attribute__((ext_vector_type(2)));
typedef unsigned v4u __attribute__((ext_vector_type(4)));
typedef __bf16 bf16x2_t __attribute__((ext_vector_type(2)));

constexpr int D = 2048, SEQ = 16384, NS = 512, M = SEQ + NS, FF = 8192, NH = 16, DH = 128, PAST = 2048, DECB = 32, DECT = 16, PST = 15;
constexpr int FFP = FF + 64;
constexpr int WIN_LD = 3 * D + NH;
constexpr float ALPHA = 1.41421356237309515f, LN_EPS = 1e-5f;
constexpr float LOG2E = 1.4426950408889634f;
constexpr float QSCALE = 0.08838834764831845f * 1.4426950408889634f;

constexpr size_t O_YP = 0, O_YS = 33554432, O_PP = 34603008, O_PS = 34633728, O_KP = 35616768, O_VP = 69171200, O_LP = 102725632, O_KS = 102987776, O_VS = 104036352, O_LS = 105084928, O_END = 105093120;

constexpr size_t MiB = 1u << 20;
constexpr size_t WS_CTL = 0, CTL_ZERO_BYTES = 1 * MiB;
constexpr size_t WS_W13 = 2 * MiB;
constexpr size_t WS_W2T = 258 * MiB;
constexpr size_t WS_WIN = 388 * MiB;
constexpr size_t WS_WO = 412 * MiB;
constexpr size_t WS_POOLT = 420 * MiB;
constexpr size_t WS_S = 422 * MiB;
constexpr size_t WS_XBF = 554 * MiB;
constexpr size_t WS_HB = 620 * MiB;
constexpr size_t WS_DB = 888 * MiB;
constexpr size_t WS_QB = 954 * MiB, WS_KB = 1020 * MiB, WS_VB = 1086 * MiB;
constexpr size_t WS_VT = 1152 * MiB;
constexpr size_t WS_OB = 1216 * MiB;
constexpr size_t WS_CL = 1282 * MiB;
constexpr size_t WS_ZS = 1283 * MiB;
constexpr size_t WS_ST = 1287 * MiB;
constexpr size_t WS_SLAB = 1289 * MiB;
constexpr size_t WS_END = 1321 * MiB;
static_assert(WS_W2T + (size_t)4 * D * FFP * 2 <= WS_WIN && WS_HB + (size_t)M * FFP * 2 <= WS_DB && WS_VB - WS_KB == WS_KB - WS_QB, "d_ws map");
constexpr int CW_TMO = 0, CW_BAR = 4096, CW_KMAX = 65536, CW_VTQ = 8256, CW_Q1 = 8320, CW_Q2 = 8384, CW_CQ = 8448, CW_CD = 8768, CW_DY = 9088;
constexpr float SKIP_THR = 24.0f;

namespace pg8 {
constexpr int BM = 256, BK = 64, HALF = 128, HTB = HALF * BK * 2, STAGE_BYTES = 8 * HTB, NXCD = 8, WGM = 8;
__host__ __device__ __forceinline__ int lds_byte(int r, int c) { const int st = (r >> 4) * 2 + (c >> 5), rr = r & 15, cc = c & 31, ob = rr * 64 + cc * 2; return st * 1024 + (ob ^ (((ob >> 9) & 1) << 5)); }
__host__ __device__ __forceinline__ void stage_rc(int b, int& R, int& C) { const int st = b / 1024, sb = b % 1024, swz = sb ^ (((sb >> 9) & 1) << 5); R = (st >> 1) * 16 + swz / 64; C = (st & 1) * 32 + (swz % 64) / 2; }
__host__ __device__ __forceinline__ int perm32(int rho) { const int n = rho >> 4, i = rho & 15; return 8 * (i >> 2) + 4 * n + (i & 3); }

struct Unit { int pm, pn, ks, nt; };
struct Gemm { const bf16* A; const bf16* Bt; int lda, ldb, K; size_t kstepA, kstepB; };

struct StaticOrder {
    int nM, nN, nwg, G, c, gdiv; unsigned gkb; int ksplit, ksub, nsub, nsub_c, ntfull, wgm, pmoff;
    __device__ __forceinline__ void init(int Mrows, int N_, int G_, int c_, int Kfull, int gdiv_ = 0, unsigned gkb_ = 0, int ksplit_ = 0, int wgm_ = WGM, int pmoff_ = 0) {
        pmoff = pmoff_; wgm = wgm_; nN = N_ / BM; G = G_; c = c_; gdiv = gdiv_; gkb = gkb_; ksplit = ksplit_; ntfull = Kfull / BK;
        if (ksplit) { nM = SEQ / BM; ksub = Kfull / ksplit; nsub = (NS / BM) * nN * ksplit; nsub_c = (c < nsub) ? (nsub - c + G - 1) / G : 0; }
        else { nM = Mrows / BM; ksub = 0; nsub = 0; nsub_c = 0; }
        nwg = nM * nN;
    }
    int dynL = 0x7fffffff; unsigned* dynw = nullptr; LAS unsigned* dynl = nullptr;
    __device__ __forceinline__ void decode(int L, Unit& u) const {
        int wgid = L; { const int q = nwg / NXCD, r = nwg % NXCD, xcd = wgid % NXCD, off = wgid / NXCD; wgid = (xcd < r ? xcd * (q + 1) : r * (q + 1) + (xcd - r) * q) + off; }
        const int nig = wgm * nN, gid = wgid / nig, fm = gid * wgm, gsz = (nM - fm) < wgm ? (nM - fm) : wgm;
        u.pm = pmoff + fm + ((wgid % nig) % gsz); u.pn = (wgid % nig) / gsz; u.ks = -1; u.nt = ntfull;
    }
    __device__ __forceinline__ bool next(int i, Unit& u) const {
        if (i < nsub_c) { const int L = i * G + c; u.ks = L % ksplit; const int t = L / ksplit; u.pn = t % nN; u.pm = SEQ / BM + t / nN; u.nt = ksub / BK; return true; }
        const long L = (long)(i - nsub_c) * G + c; if (L >= nwg || L >= dynL) return false;
        decode((int)L, u); return true;
    }
    __device__ __forceinline__ bool claim(Unit& u, int tid) const {
        if (tid == 0) { const unsigned v = __hip_atomic_fetch_add(dynw, 1u, __ATOMIC_RELAXED, __HIP_MEMORY_SCOPE_AGENT); *dynl = v; asm volatile("s_waitcnt lgkmcnt(0)" ::: "memory"); }
        asm volatile("" ::: "memory"); __builtin_amdgcn_s_barrier(); asm volatile("" ::: "memory");
        const long L = (long)dynL + (long)*dynl;
        if (L >= nwg) return false;
        decode((int)L, u); return true;
    }
    __device__ __forceinline__ size_t a_goff(const Unit& u) const { return gdiv ? (size_t)(u.pn / gdiv) * gkb : (size_t)0; }
    __device__ __forceinline__ int ktile0(const Unit& u) const { return u.ks > 0 ? u.ks * (ksub / BK) : 0; }
};

__device__ __forceinline__ unsigned cvt_pk_bf16(float lo, float hi) { unsigned r; asm volatile("v_cvt_pk_bf16_f32 %0, %1, %2" : "=v"(r) : "v"(lo), "v"(hi)); return r; }


struct EpiSwiglu {
    static constexpr bool PERM = true;
    bf16* Hout;
    __device__ __forceinline__ void operator()(const f32x4 (&acc)[2][2][4][2], const Unit& u, int wr, int wc, int fr, int fq) const {
        const int row0 = u.pm * BM + wr * 64 + fr, col0 = u.pn * HALF + wc * 32 + 8 * fq;
#pragma unroll
        for (int ai = 0; ai < 2; ++ai)
#pragma unroll
            for (int m = 0; m < 4; ++m) {
                bf16* rowp = Hout + ((size_t)(col0 >> 6) * M + (row0 + ai * HALF + m * 16)) * 64 + (col0 & 63);
                float hv[8];
#pragma unroll
                for (int n = 0; n < 2; ++n)
#pragma unroll
                    for (int j = 0; j < 4; ++j) { const float a = acc[ai][0][m][n][j], b = acc[ai][1][m][n][j];
                        const float sg = __builtin_amdgcn_rcpf(1.0f + __builtin_amdgcn_exp2f(-a * LOG2E)); hv[n * 4 + j] = a * sg * b; }
                u32x4 w; w.x = cvt_pk_bf16(hv[0], hv[1]); w.y = cvt_pk_bf16(hv[2], hv[3]); w.z = cvt_pk_bf16(hv[4], hv[5]); w.w = cvt_pk_bf16(hv[6], hv[7]);
                *(u32x4*)rowp = w; }
    }
};
struct EpiResid {
    static constexpr bool PERM = true;
    float* S; const float* srcP; const float* srcS; float r; const float* cs; float* Zs;
    float* slab;
    const float* st; const float* lg; const float* lb;
    const bf16* xb = nullptr;
    __device__ __forceinline__ void operator()(const f32x4 (&acc)[2][2][4][2], const Unit& u, int wr, int wc, int fr, int fq) const {
        const int col0 = u.pn * BM + wc * 32 + 8 * fq; const int rowb = u.pm * BM + wr * 64 + fr;
        if (u.ks >= 0) {
            bf16* zb = (bf16*)slab + ((size_t)u.ks * NS + (rowb - SEQ)) * D + col0;
#pragma unroll
            for (int bj = 0; bj < 2; ++bj) {
                f32x4 s0 = cs ? *(const f32x4*)(cs + col0 + bj * HALF) : (f32x4){1.f, 1.f, 1.f, 1.f}, s1 = cs ? *(const f32x4*)(cs + col0 + bj * HALF + 4) : (f32x4){1.f, 1.f, 1.f, 1.f}; s0 = s0 * r; s1 = s1 * r;
#pragma unroll
                for (int ai = 0; ai < 2; ++ai)
#pragma unroll
                    for (int m = 0; m < 4; ++m) { const f32x4 o0 = acc[ai][bj][m][0] * s0, o1 = acc[ai][bj][m][1] * s1;
                        u32x4 w; w.x = cvt_pk_bf16(o0[0], o0[1]); w.y = cvt_pk_bf16(o0[2], o0[3]); w.z = cvt_pk_bf16(o1[0], o1[1]); w.w = cvt_pk_bf16(o1[2], o1[3]);
                        *(u32x4*)(zb + (size_t)(ai * HALF + m * 16) * D + bj * HALF) = w; } }
            return;
        }
        const bool prm = u.pm < SEQ / BM;
        const float* src = prm ? srcP : (srcS - (size_t)SEQ * D);
        float* dst = prm ? S : (Zs - (size_t)SEQ * D);
        f32x4 sc[2][2];
#pragma unroll
        for (int bj = 0; bj < 2; ++bj)
#pragma unroll
            for (int n = 0; n < 2; ++n) { sc[bj][n] = cs ? *(const f32x4*)(cs + col0 + bj * HALF + 4 * n) : (f32x4){1.f, 1.f, 1.f, 1.f}; sc[bj][n] = sc[bj][n] * r; }
        if (st != nullptr && prm) {
            const unsigned offb = (unsigned)rowb * (unsigned)D + (unsigned)col0;
#pragma unroll
            for (int ai = 0; ai < 2; ++ai) {
                f32x2 ms[4];
#pragma unroll
                for (int m = 0; m < 4; ++m) ms[m] = *(const f32x2*)(st + 2u * (unsigned)(rowb + ai * HALF + m * 16));
#pragma unroll
                for (int bj = 0; bj < 2; ++bj) { const unsigned co = (unsigned)(bj * HALF);
                    const f32x4 g0 = *(const f32x4*)(lg + col0 + co) * ALPHA, g1 = *(const f32x4*)(lg + col0 + co + 4) * ALPHA, b0 = *(const f32x4*)(lb + col0 + co) * ALPHA, b1 = *(const f32x4*)(lb + col0 + co + 4) * ALPHA;
                    u32x4 zr[4];
#pragma unroll
                    for (int m = 0; m < 4; ++m) zr[m] = *(const u32x4*)((const bf16*)src + (offb + (unsigned)((ai * HALF + m * 16) * D) + co));
#pragma unroll
                    for (int m = 0; m < 4; ++m) { const u32x4 zq = zr[m];
                        const f32x4 z0 = {__builtin_bit_cast(float, zq.x << 16), __builtin_bit_cast(float, zq.x & 0xffff0000u), __builtin_bit_cast(float, zq.y << 16), __builtin_bit_cast(float, zq.y & 0xffff0000u)};
                        const f32x4 z1 = {__builtin_bit_cast(float, zq.z << 16), __builtin_bit_cast(float, zq.z & 0xffff0000u), __builtin_bit_cast(float, zq.w << 16), __builtin_bit_cast(float, zq.w & 0xffff0000u)};
                        const f32x4 o0 = (z0 - ms[m].x) * ms[m].y * g0 + b0 + acc[ai][bj][m][0] * sc[bj][0], o1 = (z1 - ms[m].x) * ms[m].y * g1 + b1 + acc[ai][bj][m][1] * sc[bj][1];
                        u32x4 w; w.x = cvt_pk_bf16(o0[0], o0[1]); w.y = cvt_pk_bf16(o0[2], o0[3]); w.z = cvt_pk_bf16(o1[0], o1[1]); w.w = cvt_pk_bf16(o1[2], o1[3]);
                        *(u32x4*)((bf16*)dst + (offb + (unsigned)((ai * HALF + m * 16) * D) + co)) = w; }
                    asm volatile("" ::: "memory"); } }
            return;
        }
#pragma unroll
        for (int ai = 0; ai < 2; ++ai)
#pragma unroll
            for (int m = 0; m < 4; ++m) { const size_t off = (size_t)(rowb + ai * HALF + m * 16) * D + col0;
#pragma unroll
                for (int bj = 0; bj < 2; ++bj) { f32x4 x0, x1;
                    if (prm && xb != nullptr) { const u32x4 xq = *(const u32x4*)(xb + off + bj * HALF);
                        x0 = (f32x4){__builtin_bit_cast(float, xq.x << 16), __builtin_bit_cast(float, xq.x & 0xffff0000u), __builtin_bit_cast(float, xq.y << 16), __builtin_bit_cast(float, xq.y & 0xffff0000u)};
                        x1 = (f32x4){__builtin_bit_cast(float, xq.z << 16), __builtin_bit_cast(float, xq.z & 0xffff0000u), __builtin_bit_cast(float, xq.w << 16), __builtin_bit_cast(float, xq.w & 0xffff0000u)}; }
                    else { x0 = *(const f32x4*)(src + off + bj * HALF); x1 = *(const f32x4*)(src + off + bj * HALF + 4); }
                    const f32x4 o0 = x0 * ALPHA + acc[ai][bj][m][0] * sc[bj][0], o1 = x1 * ALPHA + acc[ai][bj][m][1] * sc[bj][1];
                    if (prm) { u32x4 w; w.x = cvt_pk_bf16(o0[0], o0[1]); w.y = cvt_pk_bf16(o0[2], o0[3]); w.z = cvt_pk_bf16(o1[0], o1[1]); w.w = cvt_pk_bf16(o1[2], o1[3]);
                        *(u32x4*)((bf16*)dst + off + bj * HALF) = w; }
                    else { *(f32x4*)(dst + off + bj * HALF) = o0; *(f32x4*)(dst + off + bj * HALF + 4) = o1; } }
                asm volatile("" ::: "memory"); }
    }
};
struct EpiQKV {
    static constexpr bool PERM = false;
    bf16* Q; size_t bstride; float *kP, *kS; bf16* VT; unsigned* kq;
    __device__ __forceinline__ void operator()(const f32x4 (&acc)[2][2][4][2], const Unit& u, int wr, int wc, int fr, int fq) const {
        const int t = u.pn >> 3, colt = (u.pn & 7) * BM; const int rowb = u.pm * BM + wr * 64 + fr, col0 = colt + wc * 32 + 4 * fq;
        const int colb = colt + wc * 32 + ((fq & 1) ? 16 + 4 * (fq - 1) : 4 * fq);
        bf16* ob = Q + (size_t)t * bstride;
        const size_t tv = (t == 2) ? 1 : 0;
        float* of = (rowb < SEQ) ? (kP + tv * (O_VP - O_KP)) : (kS + tv * (O_VS - O_KS) - (size_t)SEQ * D);
        const float sc = (t == 0) ? QSCALE : 1.0f;
#pragma unroll
        for (int ai = 0; ai < 2; ++ai)
#pragma unroll
            for (int m = 0; m < 4; ++m) { const size_t off = (size_t)(rowb + ai * HALF + m * 16) * D + col0;
#pragma unroll
                for (int bj = 0; bj < 2; ++bj) { const f32x4 v0 = acc[ai][bj][m][0], v1 = acc[ai][bj][m][1];
                    if (t != 2 || rowb >= SEQ) {
                        unsigned a0 = cvt_pk_bf16(v0[0] * sc, v0[1] * sc), a1 = cvt_pk_bf16(v0[2] * sc, v0[3] * sc), b0 = cvt_pk_bf16(v1[0] * sc, v1[1] * sc), b1 = cvt_pk_bf16(v1[2] * sc, v1[3] * sc);
                        { auto r0 = __builtin_amdgcn_permlane16_swap(a0, b0, false, false); a0 = r0[0]; b0 = r0[1]; }
                        { auto r1 = __builtin_amdgcn_permlane16_swap(a1, b1, false, false); a1 = r1[0]; b1 = r1[1]; }
                        u32x4 w; w.x = a0; w.y = a1; w.z = b0; w.w = b1;
                        *(u32x4*)(ob + (size_t)(rowb + ai * HALF + m * 16) * D + colb + bj * HALF) = w; }
                    if (t != 0) { *(f32x4*)(of + off + bj * HALF) = v0; *(f32x4*)(of + off + bj * HALF + 16) = v1; } } }
        if (t == 1 && rowb < SEQ) {
#pragma unroll
            for (int bj = 0; bj < 2; ++bj) { float mx = 0.f;
#pragma unroll
                for (int ai = 0; ai < 2; ++ai)
#pragma unroll
                    for (int m = 0; m < 4; ++m) { float s = 0.f;
#pragma unroll
                        for (int n = 0; n < 2; ++n)
#pragma unroll
                            for (int j = 0; j < 4; ++j) { const float kb = __builtin_bit_cast(float, cvt_pk_bf16(0.f, acc[ai][bj][m][n][j]) & 0xffff0000u); s += kb * kb; }
                        s += __shfl_xor(s, 16); s += __shfl_xor(s, 32); mx = fmaxf(mx, s); }
                mx = fmaxf(mx, __shfl_xor(mx, 1)); mx = fmaxf(mx, __shfl_xor(mx, 2)); mx = fmaxf(mx, __shfl_xor(mx, 4)); mx = fmaxf(mx, __shfl_xor(mx, 8));
                if (fr == 0 && fq == 0) kq[((((colt + bj * HALF) >> 7) * 4 + wc) * (SEQ / BM) + u.pm) * 2 + wr] = __float_as_uint(mx); }
        }
        if (t == 2 && rowb < SEQ) {
            bf16* vt = VT; const int qi = fr & 3; const bool od1 = (qi & 1) != 0, od2 = (qi & 2) != 0;
#define QX1(x) __builtin_bit_cast(float, __builtin_amdgcn_mov_dpp(__builtin_bit_cast(int, (x)), 0xB1, 0xF, 0xF, true))
#define QX2(x) __builtin_bit_cast(float, __builtin_amdgcn_mov_dpp(__builtin_bit_cast(int, (x)), 0x4E, 0xF, 0xF, true))
#pragma unroll
            for (int bj = 0; bj < 2; ++bj)
#pragma unroll
                for (int n = 0; n < 2; ++n) { const int dg = col0 + bj * HALF + 16 * n + qi, h = dg >> 7, d = dg & 127;
#pragma unroll
                    for (int ai = 0; ai < 2; ++ai)
#pragma unroll
                        for (int m = 0; m < 4; ++m) { const f32x4 a = acc[ai][bj][m][n];
                            const float r0 = QX1(od1 ? a[0] : a[1]), r1 = QX1(od1 ? a[2] : a[3]);
                            const float lo0 = od1 ? r0 : a[0], hi0 = od1 ? a[1] : r0;
                            const float lo1 = od1 ? r1 : a[2], hi1 = od1 ? a[3] : r1;
                            const float t0 = QX2(od2 ? lo0 : lo1), t1 = QX2(od2 ? hi0 : hi1);
                            const float w0 = od2 ? t0 : lo0, w1 = od2 ? t1 : hi0, w2 = od2 ? lo1 : t0, w3 = od2 ? hi1 : t1;
                            const int s4 = (rowb - qi) + ai * HALF + m * 16;
                            u32x2 pk; pk.x = cvt_pk_bf16(w0, w1); pk.y = cvt_pk_bf16(w2, w3);
                            *(u32x2*)(vt + (((size_t)h * (SEQ / 64) + (s4 >> 6)) * DH + d) * 64 + (s4 & 63)) = pk; } }
#undef QX1
#undef QX2
        }
    }
};

template <class Epi, class Sched, bool ALIGN_EPI = true>
__device__ __forceinline__ void gemm_phase(LAS unsigned char* lds, const Gemm g, const Sched& S, const Epi& E, const int tid) {
    const int wid = __builtin_amdgcn_readfirstlane(tid >> 6), lane = tid & 63, wr = wid >> 2, wc = wid & 3, fr = lane & 15, fq = lane >> 4;
    unsigned voffA[2], voffB[2];
#pragma unroll
    for (int i = 0; i < 2; ++i) { int R, C; stage_rc(tid * 16 + i * 8192, R, C); const int Rb = Epi::PERM ? ((R & ~31) + perm32(R & 31)) : R;
        voffA[i] = (unsigned)(R * g.lda + C) * 2u; voffB[i] = (unsigned)(Rb * g.ldb + C) * 2u; }
    const size_t kstepA = g.kstepA, kstepB = g.kstepB;
    const size_t hstepA = (size_t)HALF * g.lda * 2, hstepB = (size_t)HALF * g.ldb * 2;
    const size_t tstepA = 2 * hstepA, tstepB = 2 * hstepB;
    const unsigned ldsw = (unsigned)wid * 1024u;
    const int aoff = lds_byte(wr * 64 + fr, fq * 8), boff = lds_byte(wc * 32 + fr, fq * 8);
#define PG8_SA(b, h) (((b) * 2 + (h)) * HTB)
#define PG8_SB(b, h) ((4 + (b) * 2 + (h)) * HTB)
#define PG8_STAGE(bufoff, gbase, voff) do { _Pragma("unroll") for (int _i = 0; _i < 2; ++_i) \
        __builtin_amdgcn_global_load_lds((const unsigned*)((const char*)(gbase) + (voff)[_i]), (LAS unsigned*)(lds + (bufoff) + ldsw + _i * 8192), 16, 0, 0); } while (0)
#define PG8_LDA(dst, b, h) do { _Pragma("unroll") for (int m = 0; m < 4; ++m) _Pragma("unroll") for (int k = 0; k < 2; ++k) dst[m][k] = *(const LAS bf16x8*)(lds + PG8_SA(b, h) + aoff + m * 2048 + k * 1024); } while (0)
#define PG8_LDB(dst, b, h) do { _Pragma("unroll") for (int n = 0; n < 2; ++n) _Pragma("unroll") for (int k = 0; k < 2; ++k) dst[n][k] = *(const LAS bf16x8*)(lds + PG8_SB(b, h) + boff + n * 2048 + k * 1024); } while (0)
#define PG8_MMA(ai, bj, At, Bt) do { __builtin_amdgcn_s_setprio(1); _Pragma("unroll") for (int m = 0; m < 4; ++m) _Pragma("unroll") for (int n = 0; n < 2; ++n) _Pragma("unroll") for (int k = 0; k < 2; ++k) \
        acc[ai][bj][m][n] = __builtin_amdgcn_mfma_f32_16x16x32_bf16(Bt[n][k], At[m][k], acc[ai][bj][m][n], 0, 0, 0); __builtin_amdgcn_s_setprio(0); } while (0)
#define PG8_WAIT_V(n) asm volatile("s_waitcnt vmcnt(" #n ")" ::: "memory")
#define PG8_WAIT_L(n) asm volatile("s_waitcnt lgkmcnt(" #n ")" ::: "memory")
#define PG8_BAR __builtin_amdgcn_s_barrier()
#define PG8_SCHED __builtin_amdgcn_sched_barrier(0)
    Unit cur, nxt; int ui = 0;
    if (!S.next(0, cur)) return;
    f32x4 acc[2][2][4][2];
#pragma unroll
    for (int a = 0; a < 2; ++a)
#pragma unroll
        for (int b = 0; b < 2; ++b)
#pragma unroll
            for (int m = 0; m < 4; ++m)
#pragma unroll
                for (int n = 0; n < 2; ++n) acc[a][b][m][n] = (f32x4){0.f, 0.f, 0.f, 0.f};
    bf16x8 At[4][2], B0[2][2], B1[2][2];
    const char* cA = (const char*)g.A + (size_t)cur.pm * tstepA + S.a_goff(cur) + (size_t)S.ktile0(cur) * kstepA; const char* cB = (const char*)g.Bt + (size_t)cur.pn * tstepB + (size_t)S.ktile0(cur) * kstepB;
    PG8_STAGE(PG8_SB(0, 0), cB, voffB); PG8_STAGE(PG8_SB(0, 1), cB + hstepB, voffB); PG8_STAGE(PG8_SA(0, 0), cA, voffA); PG8_STAGE(PG8_SA(0, 1), cA + hstepA, voffA);
    if (wr == 1) PG8_BAR;
    PG8_WAIT_V(2); PG8_BAR;
    PG8_STAGE(PG8_SB(1, 0), cB + kstepB, voffB); PG8_STAGE(PG8_SA(1, 0), cA + kstepA, voffA); PG8_STAGE(PG8_SB(1, 1), cB + hstepB + kstepB, voffB);
    PG8_WAIT_V(6); PG8_BAR;
    for (;;) {
        bool has_next = S.next(ui + 1, nxt);
        if (!has_next && S.dynw != nullptr) has_next = S.claim(nxt, tid);
        const char* nA = has_next ? (const char*)g.A + (size_t)nxt.pm * tstepA + S.a_goff(nxt) + (size_t)S.ktile0(nxt) * kstepA : cA; const char* nB = has_next ? (const char*)g.Bt + (size_t)nxt.pn * tstepB + (size_t)S.ktile0(nxt) * kstepB : cB;
        const int nt = cur.nt;
        for (int t = 0; t < nt; t += 2) {
            const bool last = (t == nt - 2);
            const char* a1 = cA + (size_t)(t + 1) * kstepA;
            const char* a2 = last ? nA : cA + (size_t)(t + 2) * kstepA; const char* b2 = last ? nB : cB + (size_t)(t + 2) * kstepB;
            const char* a3 = a2 + kstepA; const char* b3 = b2 + kstepB;
            PG8_LDB(B0, 0, 0); PG8_LDB(B1, 0, 1); PG8_SCHED; PG8_LDA(At, 0, 0); PG8_STAGE(PG8_SA(1, 1), a1 + hstepA, voffA);
            PG8_WAIT_V(8); PG8_WAIT_L(0); PG8_BAR; PG8_MMA(0, 0, At, B0); PG8_MMA(0, 1, At, B1); PG8_BAR; PG8_SCHED;
            PG8_LDA(At, 0, 1); PG8_STAGE(PG8_SB(0, 0), b2, voffB); PG8_STAGE(PG8_SB(0, 1), b2 + hstepB, voffB); PG8_STAGE(PG8_SA(0, 0), a2, voffA);
            PG8_WAIT_V(8); PG8_WAIT_L(0); PG8_BAR; PG8_MMA(1, 0, At, B0); PG8_MMA(1, 1, At, B1); PG8_BAR; PG8_SCHED;
            PG8_LDB(B0, 1, 0); PG8_LDB(B1, 1, 1); PG8_SCHED; PG8_LDA(At, 1, 0); PG8_STAGE(PG8_SA(0, 1), a2 + hstepA, voffA);
            PG8_WAIT_V(8); PG8_WAIT_L(0); PG8_BAR; PG8_MMA(0, 0, At, B0); PG8_MMA(0, 1, At, B1); PG8_BAR; PG8_SCHED;
            PG8_LDA(At, 1, 1); PG8_STAGE(PG8_SB(1, 0), b3, voffB); PG8_STAGE(PG8_SB(1, 1), b3 + hstepB, voffB); PG8_STAGE(PG8_SA(1, 0), a3, voffA);
            PG8_WAIT_V(8); PG8_WAIT_L(0); PG8_BAR; PG8_MMA(1, 0, At, B0); PG8_MMA(1, 1, At, B1); PG8_BAR; PG8_SCHED;
        }
        if constexpr (ALIGN_EPI) { if (wr == 0) PG8_BAR; }
        E(acc, cur, wr, wc, fr, fq);
        if (!has_next) break;
#pragma unroll
        for (int a = 0; a < 2; ++a)
#pragma unroll
            for (int b = 0; b < 2; ++b)
#pragma unroll
                for (int m = 0; m < 4; ++m)
#pragma unroll
                    for (int n = 0; n < 2; ++n) acc[a][b][m][n] = (f32x4){0.f, 0.f, 0.f, 0.f};
        cur = nxt; cA = nA; cB = nB; ++ui;
        if constexpr (ALIGN_EPI) { if (wr == 1) PG8_BAR; }
    }
    PG8_WAIT_V(0);
    if constexpr (!ALIGN_EPI) { if (wr == 0) PG8_BAR; }
    PG8_BAR;
#undef PG8_SA
#undef PG8_SB
#undef PG8_STAGE
#undef PG8_LDA
#undef PG8_LDB
#undef PG8_MMA
#undef PG8_WAIT_V
#undef PG8_WAIT_L
#undef PG8_BAR
#undef PG8_SCHED
}
}

constexpr int NWAVES = 8;
constexpr int RING_OFF = 0, RING_BYTES = 131072;
constexpr int LDSCTL_OFF = RING_BYTES, MISC_OFF = LDSCTL_OFF + 320;
constexpr int LDS_BYTES = 147456;

typedef GAS unsigned gu32;
#define RLX_AGENT __ATOMIC_RELAXED, __HIP_MEMORY_SCOPE_AGENT
#define LDS_WAIT() asm volatile("s_waitcnt lgkmcnt(0)" ::: "memory")
#define VM_WAIT() asm volatile("s_waitcnt vmcnt(0)" ::: "memory")
__device__ __forceinline__ unsigned f2bf(float f) { unsigned u = __builtin_bit_cast(unsigned, f); return (u + 0x7fffu + ((u >> 16) & 1u)) >> 16; }
__device__ __forceinline__ unsigned pk2(float lo, float hi) { return f2bf(lo) | (f2bf(hi) << 16); }
__device__ __forceinline__ unsigned cvtpk(float lo, float hi) { f32x2 v = {lo, hi}; bf16x2_t b = __builtin_convertvector(v, bf16x2_t); return __builtin_bit_cast(unsigned, b); }
__device__ __forceinline__ float bf_lo(unsigned w) { return __builtin_bit_cast(float, w << 16); }
__device__ __forceinline__ float bf_hi(unsigned w) { return __builtin_bit_cast(float, w & 0xffff0000u); }

#define XB_TMO      128
#define XB_XCNT(j)  (256  + 64 * (j))
#define XB_XSUB(j)  (1280 + 64 * (j))
#define XB_XGEN(j)  (2304 + 64 * (j))
#define XB_TOP      3328
#define XB_TOPGEN   3392
#define XCD_BAR_WORDS 3456
#define XB_SPIN_CAP (1u << 18)
__device__ __forceinline__ unsigned xb_ld(unsigned* p)              { return __hip_atomic_load(p, __ATOMIC_RELAXED, __HIP_MEMORY_SCOPE_AGENT); }
__device__ __forceinline__ unsigned xb_add(unsigned* p, unsigned v) { return __hip_atomic_fetch_add(p, v, __ATOMIC_RELAXED, __HIP_MEMORY_SCOPE_AGENT); }
__device__ __forceinline__ unsigned xb_xcc_id() { return (unsigned)__builtin_amdgcn_s_getreg((3 << 11) | 20) & 0xFu; }
#define XB_SPIN(cond, bar) do { unsigned _sp = 0; while (cond) { __builtin_amdgcn_s_sleep(1); \
    if ((++_sp & 255u) == 0u) { if (xb_ld(&(bar)[XB_TMO])) break; if (_sp > XB_SPIN_CAP) { atomicAdd(&(bar)[XB_TMO], 1u); break; } } } } while (0)
struct XcdBarrier { unsigned* bar; unsigned x; volatile LAS unsigned* st; };
__device__ __forceinline__ XcdBarrier xcd_barrier_post(unsigned* bar, volatile LAS unsigned* st, const int tid) {
    XcdBarrier b; b.bar = bar; b.x = xb_xcc_id(); b.st = st;
    if (tid == 0) (void)xb_add(&bar[XB_XCNT(b.x)], 1u);
    return b;
}
__device__ __forceinline__ void xcd_barrier_complete(unsigned* bar, unsigned x, unsigned& nloc, unsigned& nx) {
    const unsigned G = gridDim.x * gridDim.y * gridDim.z;
    unsigned sum, cnt, mine, sp = 0u;
    for (;;) {
        sum = 0u; cnt = 0u; mine = 0u;
#pragma unroll
        for (unsigned j = 0; j < 16; ++j) { const unsigned c = xb_ld(&bar[XB_XCNT(j)]); sum += c; cnt += (c > 0u) ? 1u : 0u; mine = (j == x) ? c : mine; }
        if (sum == G) break;
        __builtin_amdgcn_s_sleep(1);
        if ((++sp & 255u) == 0u) { if (xb_ld(&bar[XB_TMO])) break; if (sp > XB_SPIN_CAP) { atomicAdd(&bar[XB_TMO], 1u); break; } }
    }
    nloc = mine > 0u ? mine : 1u; nx = cnt > 0u ? cnt : 1u;
}
__device__ __forceinline__ void xcd_barrier(const XcdBarrier& b, const int tid) {
    asm volatile("s_waitcnt vmcnt(0)" ::: "memory");
    __syncthreads();
    if (tid == 0) {
        unsigned* bar = b.bar;
        __builtin_amdgcn_s_waitcnt(0);
        unsigned nloc = b.st[0], nx = b.st[1];
        if (nloc == 0u) { xcd_barrier_complete(bar, b.x, nloc, nx); b.st[0] = nloc; b.st[1] = nx; }
        const unsigned old = xb_add(&bar[XB_XSUB(b.x)], 1u);
        const unsigned gen = old / nloc;
        if (old + 1u == (gen + 1u) * nloc) {
            __builtin_amdgcn_fence(__ATOMIC_RELEASE, "agent");
            asm volatile("s_waitcnt vmcnt(0)" ::: "memory");
            const unsigned og = xb_add(&bar[XB_TOP], 1u);
            const unsigned tg = og / nx;
            if (og + 1u == (tg + 1u) * nx) xb_add(&bar[XB_TOPGEN], 1u);
            else XB_SPIN(xb_ld(&bar[XB_TOPGEN]) == tg, bar);
            __builtin_amdgcn_fence(__ATOMIC_ACQUIRE, "agent");
            xb_add(&bar[XB_XGEN(b.x)], 1u);
            asm volatile("s_waitcnt vmcnt(0)" ::: "memory");
        } else {
            XB_SPIN(xb_ld(&bar[XB_XGEN(b.x)]) == gen, bar);
            __builtin_amdgcn_fence(__ATOMIC_ACQUIRE, "agent");
            asm volatile("s_waitcnt vmcnt(0)" ::: "memory");
        }
    }
    __syncthreads();
}

struct Frame {
    LAS unsigned char* lds;
    int tid, lane, wave, vcu, G;
    const float *xP, *xS, *spool, *cK, *cV, *cLF, *lng, *lnb, *w1, *w3, *w2, *poolw, *pools, *win, *bfg, *wo;
    float* out;
    unsigned char* ws;
    unsigned* ctl;
};

__device__ __forceinline__ float wave_sum(float v) {
#pragma unroll
    for (int o = 1; o < 64; o <<= 1) v += __shfl_xor(v, o);
    return v;
}

__device__ __forceinline__ void p0_transpose_item(const float* W, int ldw, int Kd, bf16* WT, int k0, int n0, int drow0, LAS float* scr, int lane, int ktm_rows = 0) {
#pragma unroll 8
    for (int i = 0; i < 32; ++i) { const int kk = 2 * i + (lane >> 5); scr[kk * 33 + (lane & 31)] = W[(size_t)(k0 + kk) * ldw + n0 + (lane & 31)]; }
    LDS_WAIT(); asm volatile("" ::: "memory");
    const int c = lane & 7;
#pragma unroll
    for (int j = 0; j < 4; ++j) { const int n = (lane >> 3) + 8 * j; const LAS float* s = scr + (8 * c) * 33 + n;
        v4u o; o.x = pk2(s[0 * 33], s[1 * 33]); o.y = pk2(s[2 * 33], s[3 * 33]); o.z = pk2(s[4 * 33], s[5 * 33]); o.w = pk2(s[6 * 33], s[7 * 33]);
        if (ktm_rows) *(GAS v4u*)(WT + ((size_t)(k0 >> 6) * ktm_rows + drow0 + n) * 64 + 8 * c) = o;
        else *(GAS v4u*)(WT + (size_t)(drow0 + n) * Kd + k0 + 8 * c) = o; }
    LDS_WAIT(); asm volatile("" ::: "memory");
}
constexpr int FFN_ITEMS = 3 * 8192, FFN_ITEMS_UPSLOT = 14848;
__device__ __forceinline__ void convert_ffn_item(Frame& F, int f, int q, LAS float* scr) {
    if (q < 2 * 8192) { const int which = q >> 13, r = q & 8191; const int nblk = FF / 32, kb = r / nblk, nb = r % nblk, n0 = 32 * nb;
        const float* W = (which ? F.w3 : F.w1) + (size_t)f * D * FF;
        p0_transpose_item(W, FF, D, ((bf16*)(F.ws + WS_W13)) + (size_t)f * 2 * FF * D, 64 * kb, n0, 256 * (n0 >> 7) + (n0 & 127) + 128 * which, scr, F.lane); }
    else { const int r = q - 2 * 8192; const int nblk = D / 32, kb = r / nblk, nb = r % nblk;
        p0_transpose_item(F.w2 + (size_t)f * FF * D, D, FFP, ((bf16*)(F.ws + WS_W2T)) + (size_t)f * D * FFP, 64 * kb, 32 * nb, 32 * nb, scr, F.lane, D); }
}
constexpr int CONV_CH = 32;
__device__ __forceinline__ void convert_elastic(Frame& F, int f, bool drain, unsigned* done_word) {
    if (f >= 4) return;
    LAS float* scr = (LAS float*)(F.lds + RING_OFF + F.wave * 16384);
    LAS unsigned* tick = (LAS unsigned*)(F.lds + RING_OFF + 126976);
    unsigned* head = F.ctl + CW_CQ + 64 * f;
    if (F.tid == 0 && !drain) __hip_atomic_fetch_add(done_word, 1u, __ATOMIC_RELAXED, __HIP_MEMORY_SCOPE_AGENT);
    for (;;) {
        if (F.tid == 0) {
            unsigned h = 0xffffffffu;
            if (drain || __hip_atomic_load(done_word, __ATOMIC_RELAXED, __HIP_MEMORY_SCOPE_AGENT) < (unsigned)F.G) h = __hip_atomic_fetch_add(head, (unsigned)CONV_CH, __ATOMIC_RELAXED, __HIP_MEMORY_SCOPE_AGENT);
            *tick = h;
        }
        __syncthreads();
        const unsigned h = *tick;
        __syncthreads();
        if (h >= (unsigned)FFN_ITEMS) break;
        for (int q = (int)h + F.wave; q < (int)h + CONV_CH; q += NWAVES) convert_ffn_item(F, f, q, scr);
    }
}
__device__ __forceinline__ void p0_prologue(Frame& F) {
    LAS float* scr = (LAS float*)(F.lds + RING_OFF + F.wave * 16384);
    const int gw = F.vcu * NWAVES + F.wave, NGW = F.G * NWAVES;
    constexpr int I_IN = (D / 64) * (3 * D / 32);
    constexpr int I_WO = (D / 64) * (D / 32);
    constexpr int I_PL = 4 * (512 / 64) * (512 / 32);
    constexpr int NITEMS = FFN_ITEMS + I_IN + I_WO + I_PL;
    for (int it = gw; it < NITEMS; it += NGW) {
        int r = it;
        if (r < FFN_ITEMS) { convert_ffn_item(F, 0, r, scr); continue; }
        r -= FFN_ITEMS;
        if (r < I_IN) { const int nblk = 3 * D / 32, kb = r / nblk, nb = r % nblk;
            p0_transpose_item(F.win, WIN_LD, D, ((bf16*)(F.ws + WS_WIN)), 64 * kb, 32 * nb, 32 * nb, scr, F.lane); continue; }
        r -= I_IN;
        if (r < I_WO) { const int nblk = D / 32, kb = r / nblk, nb = r % nblk;
            p0_transpose_item(F.wo, D, D, ((bf16*)(F.ws + WS_WO)), 64 * kb, 32 * nb, 32 * nb, scr, F.lane); continue; }
        r -= I_WO;
        { const int g = r >> 7, q = r & 127, kb = q >> 4, nb = q & 15;
            p0_transpose_item(F.poolw + (size_t)g * 512 * 512, 512, 512, ((bf16*)(F.ws + WS_POOLT)), 64 * kb, 32 * nb, g * 512 + 32 * nb, scr, F.lane); }
    }
    for (int m = gw; m < M; m += NGW) {
        const float* xrow = (m < SEQ) ? F.xP + (size_t)m * D : F.xS + (size_t)(m - SEQ) * D;
        const GAS f32x4* xr = (const GAS f32x4*)xrow + F.lane;
        GAS u32x2* o8 = (GAS u32x2*)(((bf16*)(F.ws + WS_XBF)) + (size_t)m * D) + F.lane;
#pragma unroll
        for (int j = 0; j < 8; ++j) { const f32x4 v = xr[64 * j]; u32x2 w; w.x = pk2(v.x, v.y); w.y = pk2(v.z, v.w); o8[64 * j] = w;
            if (m >= SEQ) ((GAS f32x4*)(((float*)(F.ws + WS_ZS)) + (size_t)(m - SEQ) * D))[F.lane + 64 * j] = v * ALPHA; }
    }
}

__device__ __forceinline__ float bfly16(float (&p)[16], int lane) {
    float q8[8], q4[4], q2[2];
    { const bool up = (lane & 32) != 0;
#pragma unroll
      for (int i = 0; i < 8; ++i) { const float keep = up ? p[i + 8] : p[i], send = up ? p[i] : p[i + 8]; q8[i] = keep + __shfl_xor(send, 32); } }
    { const bool up = (lane & 16) != 0;
#pragma unroll
      for (int i = 0; i < 4; ++i) { const float keep = up ? q8[i + 4] : q8[i], send = up ? q8[i] : q8[i + 4]; q4[i] = keep + __shfl_xor(send, 16); } }
    { const bool up = (lane & 8) != 0;
#pragma unroll
      for (int i = 0; i < 2; ++i) { const float keep = up ? q4[i + 2] : q4[i], send = up ? q4[i] : q4[i + 2]; q2[i] = keep + __shfl_xor(send, 8); } }
    float r;
    { const bool up = (lane & 4) != 0; const float keep = up ? q2[1] : q2[0], send = up ? q2[0] : q2[1]; r = keep + __shfl_xor(send, 4); }
    r += __shfl_xor(r, 2); r += __shfl_xor(r, 1);
    return r;
}
__device__ __forceinline__ void logf_rows(Frame& F, const LAS float* wft, const f32x4 (&va)[8], int rowa, const f32x4 (&vb)[8], int rowb, int lane) {
    float pa[16], pb[16];
#pragma unroll
    for (int h = 0; h < NH; ++h) {
        float xa = 0.f, xb = 0.f;
#pragma unroll
        for (int j = 0; j < 8; ++j) { const f32x4 w = *(const LAS f32x4*)(wft + h * D + 4 * lane + 256 * j);
            xa += (va[j].x * w.x + va[j].y * w.y) + (va[j].z * w.z + va[j].w * w.w); xb += (vb[j].x * w.x + vb[j].y * w.y) + (vb[j].z * w.z + vb[j].w * w.w); }
        pa[h] = xa; pb[h] = xb;
        __builtin_amdgcn_sched_barrier(0);
    }
    const float ma = bfly16(pa, lane), mb = bfly16(pb, lane);
    if ((lane & 3) == 0) {
        const int h = 8 * ((lane >> 5) & 1) + 4 * ((lane >> 4) & 1) + 2 * ((lane >> 3) & 1) + ((lane >> 2) & 1);
        const float bf = F.bfg[h];
        { const float z = ma + bf; const float lf = (z >= 0.f) ? -log1pf(expf(-z)) : (z - log1pf(expf(z)));
          float* lp = (rowa < SEQ) ? F.out + O_LP + (size_t)rowa * NH : F.out + O_LS + (size_t)(rowa - SEQ) * NH; lp[h] = lf; }
        { const float z = mb + bf; const float lf = (z >= 0.f) ? -log1pf(expf(-z)) : (z - log1pf(expf(z)));
          float* lp = (rowb < SEQ) ? F.out + O_LP + (size_t)rowb * NH : F.out + O_LS + (size_t)(rowb - SEQ) * NH; lp[h] = lf; }
    }
}
template <bool WBF, bool WPOOL, bool LOGF, bool FINAL, int NSL = 0>
__device__ __forceinline__ void ln_pass(Frame& F, const float* g, const float* b) {
    const int gw = F.vcu * NWAVES + F.wave, NGW = F.G * NWAVES, lane = F.lane;
    LAS float* wft = (LAS float*)(F.lds + RING_OFF);
    if (LOGF) {
        for (int idx = F.tid; idx < D * NH; idx += NWAVES * 64) { const int c = idx >> 4, h = idx & 15; wft[h * D + c] = F.win[(size_t)c * WIN_LD + 3 * D + h]; }
        __syncthreads();
    }
    f32x4 gv[8], bv[8];
#pragma unroll
    for (int j = 0; j < 8; ++j) { gv[j] = ((const GAS f32x4*)g)[lane + 64 * j]; bv[j] = ((const GAS f32x4*)b)[lane + 64 * j]; }
    f32x4 vp[8]; int pend = -1;
    constexpr int LNA = (NSL >= 8) ? 2 : (NSL >= 4) ? 4 : (NSL >= 2) ? 5 : 6;
    const bool heavy = gw < NS; const int nlight = NGW - NS;
    for (int it = 0;; ++it) {
        int row;
        if (heavy) { if (it > LNA) break; row = (it == 0) ? SEQ + gw : gw + NS * (it - 1); }
        else { row = NS * LNA + (gw - NS) + nlight * it; if (row >= SEQ) break; }
        float* srow = ((float*)(F.ws + WS_S)) + (size_t)row * D;
        const float* zrow = (row < SEQ) ? srow : ((float*)(F.ws + WS_ZS)) + (size_t)(row - SEQ) * D;
        f32x4 v[8]; float s = 0.f;
        if (row >= SEQ) {
#pragma unroll
            for (int j = 0; j < 8; ++j) v[j] = ((const GAS f32x4*)zrow)[lane + 64 * j];
        }
        if (row < SEQ) {
            const GAS u32x2* zb = (const GAS u32x2*)(((const bf16*)(F.ws + WS_S)) + (size_t)row * D);
#pragma unroll
            for (int j = 0; j < 8; ++j) { const u32x2 w = zb[lane + 64 * j]; v[j] = (f32x4){bf_lo(w.x), bf_hi(w.x), bf_lo(w.y), bf_hi(w.y)}; }
        }
        if (NSL > 0 && row >= SEQ) {
#pragma unroll
            for (int k = 0; k < NSL; ++k) { const GAS u32x2* sp = (const GAS u32x2*)(((bf16*)(F.ws + WS_SLAB)) + ((size_t)k * NS + (row - SEQ)) * D);
#pragma unroll
                for (int j = 0; j < 8; ++j) { const u32x2 w = sp[lane + 64 * j]; v[j] = v[j] + (f32x4){bf_lo(w.x), bf_hi(w.x), bf_lo(w.y), bf_hi(w.y)}; } }
        }
#pragma unroll
        for (int j = 0; j < 8; ++j) s += (v[j].x + v[j].y) + (v[j].z + v[j].w);
        const float mean = wave_sum(s) * (1.f / D); float s2 = 0.f;
#pragma unroll
        for (int j = 0; j < 8; ++j) { v[j] = v[j] - mean; s2 += (v[j].x * v[j].x + v[j].y * v[j].y) + (v[j].z * v[j].z + v[j].w * v[j].w); }
        const float rstd = 1.f / sqrtf(wave_sum(s2) * (1.f / D) + LN_EPS);
#pragma unroll
        for (int j = 0; j < 8; ++j) v[j] = v[j] * rstd * gv[j] + bv[j];
#ifdef PROBE_MASK_A
        if (FINAL && blockIdx.x == 0) {
            unsigned ta = 0, tb = 0;
            for (int k = 0; k < 20; ++k) { const unsigned dt = F.ctl[16384 + k + 1] - F.ctl[16384 + k]; if ((PROBE_MASK_A >> k) & 1) ta += dt; if ((PROBE_MASK_B >> k) & 1) tb += dt; }
            { const unsigned d1 = F.ctl[16384 + 21] - F.ctl[16384 + 15], d2 = F.ctl[16384 + 16] - F.ctl[16384 + 21];
              if ((PROBE_MASK_A >> 20) & 1) ta += d1; if ((PROBE_MASK_B >> 20) & 1) tb += d1; if ((PROBE_MASK_A >> 21) & 1) ta += d2; if ((PROBE_MASK_B >> 21) & 1) tb += d2; }
            { const unsigned t14 = F.ctl[16384 + 14]; const unsigned x0 = F.ctl[16384 + 50] - t14, x1 = F.ctl[16384 + 51] - F.ctl[16384 + 50], x2 = F.ctl[16384 + 52] - F.ctl[16384 + 51], y0 = F.ctl[16384 + 53] - t14, y1 = F.ctl[16384 + 54] - F.ctl[16384 + 53];
              const unsigned xs[5] = {x0, x1, x2, y0, y1};
              for (int k = 0; k < 5; ++k) { if ((PROBE_MASK_A >> (24 + k)) & 1) ta += xs[k]; if ((PROBE_MASK_B >> (24 + k)) & 1) tb += xs[k]; } }
            const float eps = (float)ta * 0.01f / (float)PROBE_TA, del = rintf((float)tb * 0.01f / (float)PROBE_TB);
            if (row >= SEQ) {
#pragma unroll
                for (int j = 0; j < 8; ++j) v[j] = v[j] + eps;
            }
            if (row == 0 && lane == 0) v[0].x += del;
        }
#endif
        if (FINAL) {
            float* orow = (row < SEQ) ? F.out + O_YP + (size_t)row * D : F.out + O_YS + (size_t)(row - SEQ) * D;
#pragma unroll
            for (int j = 0; j < 8; ++j) ((GAS f32x4*)orow)[lane + 64 * j] = v[j];
        } else if (row >= SEQ) {
#pragma unroll
            for (int j = 0; j < 8; ++j) ((GAS f32x4*)srow)[lane + 64 * j] = v[j];
#pragma unroll
            for (int j = 0; j < 8; ++j) ((GAS f32x4*)(((float*)(F.ws + WS_ZS)) + (size_t)(row - SEQ) * D))[lane + 64 * j] = v[j] * ALPHA;
        } else if (lane == 0) {
            *(GAS f32x2*)(((float*)(F.ws + WS_ST)) + 2 * (size_t)row) = (f32x2){mean, rstd};
        }
        if (WBF) {
            GAS u32x2* o8 = (GAS u32x2*)(((bf16*)(F.ws + WS_XBF)) + (size_t)row * D) + lane;
#pragma unroll
            for (int j = 0; j < 8; ++j) { u32x2 w; w.x = pk2(v[j].x, v[j].y); w.y = pk2(v[j].z, v[j].w); o8[64 * j] = w; }
        }
        if (WPOOL) {
            float* prow = nullptr;
            if (row >= SEQ - PST && row < SEQ) prow = F.out + O_PP + (size_t)(row - (SEQ - PST)) * D;
            else if (row >= SEQ) { const int bb = (row - SEQ) >> 4, i = (row - SEQ) & 15; if (i >= 1) prow = F.out + O_PS + ((size_t)bb * PST + (i - 1)) * D; }
            if (prow) {
#pragma unroll
                for (int j = 0; j < 8; ++j) ((GAS f32x4*)prow)[lane + 64 * j] = v[j];
            }
        }
        if (LOGF) {
            if (pend < 0) { pend = row;
#pragma unroll
                for (int j = 0; j < 8; ++j) vp[j] = v[j]; }
            else { logf_rows(F, wft, vp, pend, v, row, lane); pend = -1; }
        }
    }
    if (LOGF && pend >= 0) logf_rows(F, wft, vp, pend, vp, pend, lane);
    if (LOGF) __syncthreads();
}

template <int KIND>
__device__ __forceinline__ f32x4 pool_fetch(Frame& F, int b, int idx, int c4, const f32x4 g4, const f32x4 b4) {
    if (KIND == 0) { const bool ok = idx >= 0; const int r = ok ? idx : 0; const f32x2 ms = *(const GAS f32x2*)(((float*)(F.ws + WS_ST)) + 2 * (size_t)r);
        const u32x2 w = *(const GAS u32x2*)(((const bf16*)(F.ws + WS_S)) + (size_t)r * D + c4); const f32x4 x = ((f32x4){bf_lo(w.x), bf_hi(w.x), bf_lo(w.y), bf_hi(w.y)} - ms.x) * ms.y * g4 + b4;
        return ok ? x : (f32x4){0.f, 0.f, 0.f, 0.f}; }
    const float* p = (idx < PST) ? F.spool + ((size_t)b * PST + idx) * D : ((float*)(F.ws + WS_S)) + (size_t)(SEQ + b * DECT + idx - PST) * D;
    return *(const GAS f32x4*)(p + c4);
}
template <int W, int KIND>
__device__ __forceinline__ void pool_run(Frame& F, int b, int i0, int orow0, int c4, const f32x4 g4, const f32x4 b4) {
    f32x4 xs[W - 1 + 16];
#pragma unroll
    for (int k = 0; k < W - 1 + 16; ++k) xs[k] = pool_fetch<KIND>(F, b, i0 - (W - 1) + k, c4, g4, b4);
    f32x4 acc = (f32x4){0.f, 0.f, 0.f, 0.f};
#pragma unroll
    for (int k = 0; k < W - 1; ++k) acc = acc + xs[k];
#pragma unroll
    for (int e = 0; e < 16; ++e) {
        const int i = i0 + e;
        const f32x4 x = xs[W - 1 + e];
        acc = acc + x;
        const int cnti = (KIND == 0) ? ((i + 1 < W) ? i + 1 : W) : W;
        const float cnt = (float)cnti;
        const f32x4 d = acc / cnt - x;
        u32x2 o; o.x = pk2(d.x, d.y); o.y = pk2(d.z, d.w);
        *(GAS u32x2*)(((bf16*)(F.ws + WS_DB)) + (size_t)(orow0 + e) * D + c4) = o;
        acc = acc - xs[e];
    }
}
template <int KIND> __device__ __forceinline__ void pool_run_w(Frame& F, int grp, int b, int i0, int orow0, int c4, const f32x4 g4, const f32x4 b4) {
    if (grp == 0) pool_run<2, KIND>(F, b, i0, orow0, c4, g4, b4);
    else if (grp == 1) pool_run<4, KIND>(F, b, i0, orow0, c4, g4, b4);
    else if (grp == 2) pool_run<8, KIND>(F, b, i0, orow0, c4, g4, b4);
    else pool_run<16, KIND>(F, b, i0, orow0, c4, g4, b4);
}
__device__ __forceinline__ void pool_pass(Frame& F) {
    const int c4 = 4 * F.tid, grp = __builtin_amdgcn_readfirstlane(F.tid >> 7);
    const f32x4 g4 = *(const GAS f32x4*)(F.lng + c4), b4 = *(const GAS f32x4*)(F.lnb + c4);
    constexpr int NRUN_P = SEQ / 16, NRUN = NRUN_P + DECB;
    for (int run = F.vcu; run < NRUN; run += F.G) {
        if (run < NRUN_P) pool_run_w<0>(F, grp, 0, run * 16, run * 16, c4, g4, b4);
        else { const int b = run - NRUN_P; pool_run_w<1>(F, grp, b, PST, SEQ + b * DECT, c4, g4, b4); }
    }
}

__device__ __forceinline__ float block_excl_scan(float v, LAS float* buf, int tid) {
    const int lane = tid & 63, wv = tid >> 6;
    float x = v;
#pragma unroll
    for (int off = 1; off < 64; off <<= 1) { const float y = __shfl_up(x, off); if (lane >= off) x += y; }
    if (lane == 63) buf[wv] = x;
    __syncthreads();
    float base = 0.f;
#pragma unroll
    for (int k = 0; k < NWAVES; ++k) { const float t = buf[k]; if (k < wv) base += t; }
    __syncthreads();
    return base + x - v;
}

__device__ __forceinline__ void cl_scan(Frame& F, const int h) {
    const float* lf = F.out + O_LP;
    LAS float* buf = (LAS float*)(F.lds + RING_OFF);
    const int t0 = 32 * F.tid; float tot = 0.f;
#pragma unroll 8
    for (int e = 0; e < 32; ++e) tot += lf[(size_t)(t0 + e) * NH + h];
    float run = block_excl_scan(tot, buf, F.tid);
#pragma unroll 8
    for (int e = 0; e < 32; ++e) { run += lf[(size_t)(t0 + e) * NH + h]; ((float*)(F.ws + WS_CL))[(size_t)h * SEQ + t0 + e] = run * LOG2E; }
    __syncthreads();
}
__device__ __forceinline__ void kmax_pass(Frame& F, const int rank, const int nrank) {
    const int gw = rank * NWAVES + F.wave, NGW = nrank * NWAVES;
    float rmax[4] = {0.f, 0.f, 0.f, 0.f};
    for (int row = gw; row < SEQ; row += 4 * NGW) {
        u32x4 v[4][4];
#pragma unroll
        for (int r = 0; r < 4; ++r) { const int rr = (row + r * NGW < SEQ) ? row + r * NGW : row; const GAS u32x4* kp = (const GAS u32x4*)(((bf16*)(F.ws + WS_KB)) + (size_t)rr * D) + F.lane;
#pragma unroll
            for (int j = 0; j < 4; ++j) v[r][j] = kp[64 * j]; }
#pragma unroll
        for (int r = 0; r < 4; ++r)
#pragma unroll
            for (int j = 0; j < 4; ++j) { const u32x4 x = v[r][j]; float s = 0.f;
                s += bf_lo(x.x) * bf_lo(x.x) + bf_hi(x.x) * bf_hi(x.x); s += bf_lo(x.y) * bf_lo(x.y) + bf_hi(x.y) * bf_hi(x.y);
                s += bf_lo(x.z) * bf_lo(x.z) + bf_hi(x.z) * bf_hi(x.z); s += bf_lo(x.w) * bf_lo(x.w) + bf_hi(x.w) * bf_hi(x.w);
                s += __shfl_xor(s, 1); s += __shfl_xor(s, 2); s += __shfl_xor(s, 4); s += __shfl_xor(s, 8);
                rmax[j] = fmaxf(rmax[j], s); }
    }
    if ((F.lane & 15) == 0) {
#pragma unroll
        for (int j = 0; j < 4; ++j) atomicMax(F.ctl + CW_KMAX + (F.lane >> 4) + 4 * j, __float_as_uint(rmax[j]));
    }
}
__device__ __forceinline__ void vt_queue(Frame& F) {
    LAS unsigned* T = (LAS unsigned*)(F.lds + RING_OFF);
    constexpr int NIT = NH * (SEQ / 64), TSZ = 64 * 65;
    LAS unsigned* tick = T + 4 * TSZ;
    for (;;) {
        if (F.tid == 0) *tick = __hip_atomic_fetch_add(F.ctl + CW_VTQ, 4u, __ATOMIC_RELAXED, __HIP_MEMORY_SCOPE_AGENT);
        __syncthreads();
        const int it0 = (int)*tick;
        if (it0 >= NIT) break;
        u32x4 v[4][2];
#pragma unroll
        for (int r = 0; r < 4; ++r) { const int it = it0 + r; const int h = it & 15, s0 = (it >> 4) * 64;
#pragma unroll
            for (int i = 0; i < 2; ++i) { const int cidx = F.tid + 512 * i, s = cidx >> 4, dc = cidx & 15;
                v[r][i] = *(const GAS u32x4*)(((bf16*)(F.ws + WS_VB)) + (size_t)(s0 + s) * D + h * DH + 8 * dc); } }
#pragma unroll
        for (int r = 0; r < 4; ++r)
#pragma unroll
            for (int i = 0; i < 2; ++i) { const int cidx = F.tid + 512 * i, s = cidx >> 4, dc = cidx & 15;
                LAS unsigned* p = T + r * TSZ + s * 65 + 4 * dc; p[0] = v[r][i].x; p[1] = v[r][i].y; p[2] = v[r][i].z; p[3] = v[r][i].w; }
        __syncthreads();
#pragma unroll
        for (int r = 0; r < 4; ++r) { const int it = it0 + r; const int h = it & 15, s0 = (it >> 4) * 64;
#pragma unroll
            for (int i = 0; i < 2; ++i) { const int cidx = F.tid + 512 * i, d = cidx >> 3, sc = cidx & 7;
                const LAS unsigned short* ps = (const LAS unsigned short*)(T + r * TSZ) + d;
                unsigned e[8];
#pragma unroll
                for (int j = 0; j < 8; ++j) e[j] = ps[(size_t)(8 * sc + j) * 130];
                u32x4 o; o.x = e[0] | (e[1] << 16); o.y = e[2] | (e[3] << 16); o.z = e[4] | (e[5] << 16); o.w = e[6] | (e[7] << 16);
                *(GAS u32x4*)(((bf16*)(F.ws + WS_VT)) + (((size_t)h * (SEQ / 64) + (s0 >> 6)) * DH + d) * 64 + 8 * sc) = o; } }
        __syncthreads();
    }
}

#define MFMA32(a, b, c) __builtin_amdgcn_mfma_f32_32x32x16_bf16((a), (b), (c), 0, 0, 0)
__device__ __forceinline__ int kswz(int row, int colB) { return row * 256 + (colB ^ ((row & 7) << 4)); }
constexpr int AT_K = 0, AT_V = 32768, AT_C = 65536;

__device__ __forceinline__ void attn_prompt_unit(Frame& F, int h, int qb) {
    LAS unsigned char* lds = F.lds + RING_OFF;
    const int tid = F.tid, w = F.wave, lane = F.lane, c = lane & 31, hh = lane >> 5;
    const int q0 = 256 * qb + 32 * w, qrow = q0 + c;
    bf16x8 qf[8];
    { const bf16* Qp = ((bf16*)(F.ws + WS_QB)) + (size_t)qrow * D + h * DH + 8 * hh;
#pragma unroll
      for (int ch = 0; ch < 8; ++ch) qf[ch] = *(const GAS bf16x8*)(Qp + 16 * ch); }
    const float cq = ((float*)(F.ws + WS_CL))[(size_t)h * SEQ + qrow];
    f32x16 o[4];
#pragma unroll
    for (int db = 0; db < 4; ++db)
#pragma unroll
        for (int i = 0; i < 16; ++i) o[db][i] = 0.f;
    float m = -1e30f, lsum = 0.f;
    const int ntiles = 4 * qb + 4, tmax = 4 * qb + (w >> 1);
    float bnd;
    { float qn2 = 0.f;
#pragma unroll
      for (int ch = 0; ch < 8; ++ch) { const u32x4 qq = __builtin_bit_cast(u32x4, qf[ch]);
          qn2 += bf_lo(qq.x) * bf_lo(qq.x) + bf_hi(qq.x) * bf_hi(qq.x); qn2 += bf_lo(qq.y) * bf_lo(qq.y) + bf_hi(qq.y) * bf_hi(qq.y);
          qn2 += bf_lo(qq.z) * bf_lo(qq.z) + bf_hi(qq.z) * bf_hi(qq.z); qn2 += bf_lo(qq.w) * bf_lo(qq.w) + bf_hi(qq.w) * bf_hi(qq.w); }
      qn2 += __shfl_xor(qn2, 32);
      const float kmax2 = *(const LAS float*)(lds + AT_C + 1024 + 4 * h);
      bnd = sqrtf(qn2 * kmax2) * 1.001f + SKIP_THR; }
    bool done = false;
    LAS unsigned* flags = (LAS unsigned*)(lds + AT_C + 512);
    const int kr0 = tid >> 4, kc = tid & 15;
    const int vd0 = tid >> 3, vc = tid & 7;
    const unsigned char* wsb = (const unsigned char*)((float*)(F.ws + WS_S)) - WS_S;
    const unsigned koff = (unsigned)WS_KB + (unsigned)((kr0 * D + h * DH + 8 * kc) * 2);
    const unsigned voff = (unsigned)WS_VT + (unsigned)(((h * (SEQ / 64)) * DH + vd0) * 64 + 8 * vc) * 2u;
    const unsigned coff = (unsigned)WS_CL + (unsigned)((h * SEQ + (tid & 63)) * 4);
    u32x4 kst[2], vst[2]; float cst = 0.f;
#define AT_LOADK(kt) do { const unsigned _k0 = 64u * (unsigned)(kt); \
        kst[0] = *(const GAS u32x4*)(wsb + (koff + _k0 * (D * 2))); kst[1] = *(const GAS u32x4*)(wsb + (koff + _k0 * (D * 2) + 32 * D * 2)); \
        if (tid < 64) cst = *(const GAS float*)(wsb + (coff + _k0 * 4)); } while (0)
#define AT_LOADV(kt) do { const unsigned _k0 = 64u * (unsigned)(kt); \
        vst[0] = *(const GAS u32x4*)(wsb + (voff + _k0 * (DH * 2))); vst[1] = *(const GAS u32x4*)(wsb + (voff + _k0 * (DH * 2) + 64 * 64 * 2)); } while (0)
#define AT_WRITEK(buf) do { LAS unsigned char* _kb = lds + AT_K + (buf) * 16384; \
        *(LAS u32x4*)(_kb + kswz(kr0, 16 * kc)) = kst[0]; *(LAS u32x4*)(_kb + kswz(kr0 + 32, 16 * kc)) = kst[1]; \
        if (tid < 64) *(LAS float*)(lds + AT_C + (buf) * 256 + tid * 4) = cst; } while (0)
#define AT_WRITEV(buf) do { LAS unsigned char* _vb = lds + AT_V + (buf) * 16384; \
        { const int _f = (vd0 >> 1) & 15; LAS unsigned char* _r = _vb + vd0 * 128; \
          *(LAS u32x2*)(_r + (((2 * vc) ^ _f) << 3)) = (u32x2){vst[0].x, vst[0].y}; *(LAS u32x2*)(_r + (((2 * vc + 1) ^ _f) << 3)) = (u32x2){vst[0].z, vst[0].w}; } \
        { const int _d = vd0 + 64, _f = (_d >> 1) & 15; LAS unsigned char* _r = _vb + _d * 128; \
          *(LAS u32x2*)(_r + (((2 * vc) ^ _f) << 3)) = (u32x2){vst[1].x, vst[1].y}; *(LAS u32x2*)(_r + (((2 * vc + 1) ^ _f) << 3)) = (u32x2){vst[1].z, vst[1].w}; } } while (0)
    AT_LOADK(ntiles - 1); AT_LOADV(ntiles - 1); AT_WRITEK(0); AT_WRITEV(0); __syncthreads();
    int it = 0;
    for (int kt = ntiles - 1; kt >= 0; --kt, ++it) {
        const int buf = it & 1;
        const bool active = !done && kt <= tmax;
        f32x16 s0, s1;
        if (kt > 0) AT_LOADK(kt - 1);
        __builtin_amdgcn_sched_barrier(0);
        if (active) {
            const LAS unsigned char* Kb = lds + AT_K + buf * 16384;
#pragma unroll
            for (int i = 0; i < 16; ++i) { s0[i] = 0.f; s1[i] = 0.f; }
            const LAS unsigned char* Kr = Kb + c * 256;
            const int kx = (c & 7) << 4;
#pragma unroll
            for (int ch = 0; ch < 8; ++ch) {
                const int co = ((32 * (ch & 3) + 16 * hh) ^ kx) + 128 * (ch >> 2);
                const bf16x8 k0 = *(const LAS bf16x8*)(Kr + co);
                const bf16x8 k1 = *(const LAS bf16x8*)(Kr + co + 8192);
                s0 = MFMA32(k0, qf[ch], s0); s1 = MFMA32(k1, qf[ch], s1);
                __builtin_amdgcn_sched_barrier(0);
            }
        }
        __builtin_amdgcn_sched_barrier(0);
        if (kt > 0) { AT_WRITEK(buf ^ 1); AT_LOADV(kt - 1); }
        __builtin_amdgcn_sched_barrier(0);
        if (active) {
            const LAS unsigned char* Vb = lds + AT_V + buf * 16384; const LAS unsigned char* Cb = lds + AT_C + buf * 256;
#pragma unroll
            for (int g = 0; g < 4; ++g) {
                const f32x4 cb0 = *(const LAS f32x4*)(Cb + (8 * g + 4 * hh) * 4), cb1 = *(const LAS f32x4*)(Cb + (32 + 8 * g + 4 * hh) * 4);
#pragma unroll
                for (int e = 0; e < 4; ++e) { s0[4 * g + e] += cq - cb0[e]; s1[4 * g + e] += cq - cb1[e]; }
            }
            if (64 * kt + 63 > q0) {
#pragma unroll
                for (int i = 0; i < 16; ++i) { const int key = 64 * kt + (i & 3) + 8 * (i >> 2) + 4 * hh;
                    if (key > qrow) s0[i] = -INFINITY; if (key + 32 > qrow) s1[i] = -INFINITY; }
            }
            float mx = s0[0];
#pragma unroll
            for (int i = 1; i < 16; ++i) mx = fmaxf(mx, s0[i]);
#pragma unroll
            for (int i = 0; i < 16; ++i) mx = fmaxf(mx, s1[i]);
            mx = fmaxf(mx, __shfl_xor(mx, 32));
            const float mnew = fmaxf(m, mx), alpha = __builtin_amdgcn_exp2f(m - mnew); m = mnew;
            float ps = 0.f;
#pragma unroll
            for (int i = 0; i < 16; ++i) { s0[i] = __builtin_amdgcn_exp2f(s0[i] - mnew); s1[i] = __builtin_amdgcn_exp2f(s1[i] - mnew); ps += s0[i] + s1[i]; }
            lsum = lsum * alpha + ps;
            if (!__all(alpha == 1.0f)) {
#pragma unroll
                for (int db = 0; db < 4; ++db)
#pragma unroll
                    for (int i = 0; i < 16; ++i) o[db][i] *= alpha;
            }
            bf16x8 pf[2][2];
#pragma unroll
            for (int s2 = 0; s2 < 2; ++s2) {
                u32x4 a, b;
                a.x = cvtpk(s0[8 * s2 + 0], s0[8 * s2 + 1]); a.y = cvtpk(s0[8 * s2 + 2], s0[8 * s2 + 3]); a.z = cvtpk(s0[8 * s2 + 4], s0[8 * s2 + 5]); a.w = cvtpk(s0[8 * s2 + 6], s0[8 * s2 + 7]);
                b.x = cvtpk(s1[8 * s2 + 0], s1[8 * s2 + 1]); b.y = cvtpk(s1[8 * s2 + 2], s1[8 * s2 + 3]); b.z = cvtpk(s1[8 * s2 + 4], s1[8 * s2 + 5]); b.w = cvtpk(s1[8 * s2 + 6], s1[8 * s2 + 7]);
                pf[0][s2] = __builtin_bit_cast(bf16x8, a); pf[1][s2] = __builtin_bit_cast(bf16x8, b);
            }
#pragma unroll
            for (int db = 0; db < 4; ++db) {
                const int f = (c >> 1) & 15; const LAS unsigned char* rowb = Vb + c * 128 + db * 4096;
#pragma unroll
                for (int kb = 0; kb < 2; ++kb)
#pragma unroll
                    for (int s2 = 0; s2 < 2; ++s2) {
                        const int g0 = 8 * kb + 4 * s2 + hh;
                        const u32x2 lo = *(const LAS u32x2*)(rowb + ((g0 ^ f) << 3)), hi = *(const LAS u32x2*)(rowb + (((g0 + 2) ^ f) << 3));
                        const u32x4 vv = (u32x4){lo.x, lo.y, hi.x, hi.y};
                        o[db] = MFMA32(__builtin_bit_cast(bf16x8, vv), pf[kb][s2], o[db]);
                    }
                __builtin_amdgcn_sched_barrier(0);
            }
            if (kt > 0) { const float edge = *(const GAS float*)(wsb + ((unsigned)WS_CL + (unsigned)((h * SEQ + 64 * kt - 1) * 4))); done = __all(bnd + (cq - edge) < m); }
        }
        __builtin_amdgcn_sched_barrier(0);
        if (lane == 0) flags[buf * 8 + w] = done ? 1u : 0u;
        if (kt > 0) AT_WRITEV(buf ^ 1);
        __syncthreads();
        { const u32x4 f0 = *(const LAS u32x4*)(flags + buf * 8), f1 = *(const LAS u32x4*)(flags + buf * 8 + 4);
          if ((f0.x & f0.y & f0.z & f0.w & f1.x & f1.y & f1.z & f1.w) != 0u) break; }
    }
#undef AT_LOADK
#undef AT_LOADV
#undef AT_WRITEK
#undef AT_WRITEV
    const float ltot = lsum + __shfl_xor(lsum, 32), inv = 1.0f / ltot;
    bf16* Op = ((bf16*)(F.ws + WS_OB)) + (size_t)qrow * D + h * DH;
#pragma unroll
    for (int db = 0; db < 4; ++db)
#pragma unroll
        for (int g = 0; g < 4; g += 2) {
            u32x2 a, b2;
            a.x = cvtpk(o[db][4 * g] * inv, o[db][4 * g + 1] * inv); a.y = cvtpk(o[db][4 * g + 2] * inv, o[db][4 * g + 3] * inv);
            b2.x = cvtpk(o[db][4 * g + 4] * inv, o[db][4 * g + 5] * inv); b2.y = cvtpk(o[db][4 * g + 6] * inv, o[db][4 * g + 7] * inv);
            { auto r0 = __builtin_amdgcn_permlane32_swap(a.x, b2.x, false, false); a.x = r0[0]; b2.x = r0[1]; }
            { auto r1 = __builtin_amdgcn_permlane32_swap(a.y, b2.y, false, false); a.y = r1[0]; b2.y = r1[1]; }
            u32x4 wv; wv.x = a.x; wv.y = a.y; wv.z = b2.x; wv.w = b2.y;
            *(GAS u32x4*)(Op + 32 * db + 8 * g + 8 * hh) = wv;
        }
}

constexpr bool SA_KTOUCH = false;
constexpr int SA_CS = 0;
constexpr int SA_SCAN = 8448;
constexpr int SA_P = 12800;
constexpr int SA_A = 29184;
constexpr int SA_M = 29696, SA_L = 30208;
constexpr int SA_O = 32768;
__device__ __forceinline__ void attn_sample_unit(Frame& F, int b, int h) {
    LAS unsigned char* lds = F.lds + RING_OFF;
    const int tid = F.tid, w = F.wave, lane = F.lane, c = lane & 31, hh = lane >> 5, qi = c & 15;
    LAS float* cs = (LAS float*)(lds + SA_CS);
    {
        const float* lf = F.cLF + ((size_t)b * PAST) * NH + h;
        float v[4], tot = 0.f;
#pragma unroll
        for (int e = 0; e < 4; ++e) { v[e] = lf[(size_t)(4 * tid + e) * NH]; tot += v[e]; }
        float run = block_excl_scan(tot, (LAS float*)(lds + SA_SCAN), tid);
#pragma unroll
        for (int e = 0; e < 4; ++e) { run += v[e]; cs[4 * tid + e] = run * LOG2E; }
        __syncthreads();
        if (tid < 64) { const float* ln = F.out + O_LS + (size_t)(b * DECT) * NH + h;
            float x = (lane < DECT) ? ln[(size_t)lane * NH] * LOG2E : 0.f;
#pragma unroll
            for (int off = 1; off < 16; off <<= 1) { const float y = __shfl_up(x, off); if (lane >= off) x += y; }
            const float tot = __shfl(x, DECT - 1);
            if (lane < 32) cs[PAST + lane] = cs[PAST - 1] + ((lane < DECT) ? x : tot); }
        __syncthreads();
    }
    bf16x8 qf[8];
    { const bf16* Qp = ((bf16*)(F.ws + WS_QB)) + (size_t)(SEQ + b * DECT + qi) * D + h * DH + 8 * hh;
#pragma unroll
      for (int ch = 0; ch < 8; ++ch) { bf16x8 t = *(const GAS bf16x8*)(Qp + 16 * ch); if (c >= 16) t = (bf16x8){0, 0, 0, 0, 0, 0, 0, 0}; qf[ch] = t; } }
    const float cq = cs[PAST + qi];
    float m = -1e30f, lsum = 0.f;
    float oa[16][2];
#pragma unroll
    for (int q = 0; q < 16; ++q) { oa[q][0] = 0.f; oa[q][1] = 0.f; }
    LAS float* Pw = (LAS float*)(lds + SA_P + w * 2048);
    LAS float* Aw = (LAS float*)(lds + SA_A + w * 64);
    float dummy = 0.f;
    const int trow = lane >> 1, tcol = (lane & 1) * 64;
    const char* cKb = (const char*)F.cK; const char* cVb = (const char*)F.cV;
    const unsigned tile_b = 32u * NH * DH * 4u;
    LAS unsigned char* Kst = lds + SA_O + w * 8192;
    LAS unsigned char* kwb[4];
#pragma unroll
    for (int jj = 0; jj < 4; ++jj) { const int key = 2 * jj + (lane >> 5); kwb[jj] = Kst + key * 256 + (((((lane & 31) >> 1) ^ (key & 7)) << 4) + 8 * (lane & 1)); }
    const unsigned toff = (unsigned)((((b * PAST + trow) * NH + h) * DH + tcol) * 4), kcoff = (unsigned)((((b * PAST + (lane >> 5)) * NH + h) * DH + 4 * (lane & 31)) * 4), voff = (unsigned)(((b * PAST * NH + h) * DH + 2 * lane) * 4);
#define SA_TOUCHK(T_, j0, j1) do { const unsigned _o = toff + (unsigned)(T_) * tile_b; j0 = *(const GAS float*)(cKb + _o); j1 = *(const GAS float*)(cKb + (_o + 128u)); } while (0)
    float tk0 = 0.f, tk1 = 0.f;
    if (SA_KTOUCH) { const int T0 = 64 - w; if (T0 < 64) SA_TOUCHK(T0, tk0, tk1); }
    for (int T = 64 - w; T >= 0; T -= NWAVES) {
        f32x16 s;
#pragma unroll
        for (int i = 0; i < 16; ++i) s[i] = 0.f;
        if (SA_KTOUCH) { dummy += tk0 + tk1;
            if (T >= NWAVES) SA_TOUCHK(T - NWAVES, tk0, tk1); }
        if (T < 64) {
            const char* kt = cKb + (size_t)T * tile_b;
            f32x4 kr[16];
#pragma unroll
            for (int j = 0; j < 16; ++j) kr[j] = *(const GAS f32x4*)((kt + (size_t)j * (2u * NH * DH * 4u)) + kcoff);
#pragma unroll
            for (int j = 0; j < 16; ++j) { u32x2 pk; pk.x = cvtpk(kr[j].x, kr[j].y); pk.y = cvtpk(kr[j].z, kr[j].w);
                *(LAS u32x2*)(kwb[j & 3] + (j >> 2) * 2048) = pk; }
            asm volatile("s_waitcnt lgkmcnt(0)" ::: "memory"); __builtin_amdgcn_wave_barrier();
#pragma unroll
            for (int ch = 0; ch < 8; ++ch) { const bf16x8 kk = *(const LAS bf16x8*)(Kst + c * 256 + (((2 * ch + hh) ^ (c & 7)) << 4));
                s = MFMA32(kk, qf[ch], s); }
        } else {
            const bf16* kp = ((bf16*)(F.ws + WS_KB)) + (size_t)(SEQ + b * DECT + qi) * D + h * DH + 8 * hh;
#pragma unroll
            for (int ch = 0; ch < 8; ++ch) { bf16x8 kk = *(const GAS bf16x8*)(kp + 16 * ch); if (c >= 16) kk = (bf16x8){0, 0, 0, 0, 0, 0, 0, 0};
                s = MFMA32(kk, qf[ch], s); }
        }
        { const LAS float* csb = cs + 32 * T + 4 * hh;
#pragma unroll
          for (int g = 0; g < 4; ++g) { const f32x4 cb = *(const LAS f32x4*)(csb + 8 * g);
#pragma unroll
            for (int e = 0; e < 4; ++e) s[4 * g + e] += cq - cb[e]; } }
        if (T == 64) {
#pragma unroll
            for (int i = 0; i < 16; ++i) { const int kl = (i & 3) + 8 * (i >> 2) + 4 * hh; if (kl > qi) s[i] = -INFINITY; }
        }
        float mx = s[0];
#pragma unroll
        for (int i = 1; i < 16; ++i) mx = fmaxf(mx, s[i]);
        mx = fmaxf(mx, __shfl_xor(mx, 32));
        if (__all((c >= 16) || (mx < m - SKIP_THR))) continue;
        float tv0 = 0.f, tv1 = 0.f;
        if (T < 64) { const unsigned _o = toff + (unsigned)T * tile_b; tv0 = *(const GAS float*)(cVb + _o); tv1 = *(const GAS float*)(cVb + (_o + 128u)); }
        const float mnew = fmaxf(m, mx), alpha = __builtin_amdgcn_exp2f(m - mnew); m = mnew;
        float ps = 0.f;
#pragma unroll
        for (int i = 0; i < 16; ++i) { s[i] = __builtin_amdgcn_exp2f(s[i] - mnew); ps += s[i]; }
        lsum = lsum * alpha + ps;
        if (c < 16) {
            LAS float* pb = Pw + 64 * hh + c;
#pragma unroll
            for (int i = 0; i < 16; ++i) pb[((i & 3) + 8 * (i >> 2)) * 16] = s[i];
            if (hh == 0) Aw[c] = alpha;
        }
        asm volatile("s_waitcnt lgkmcnt(0)" ::: "memory"); __builtin_amdgcn_wave_barrier();
        {
            f32x4 a4[4];
#pragma unroll
            for (int j = 0; j < 4; ++j) a4[j] = *(const LAS f32x4*)(Aw + 4 * j);
#pragma unroll
            for (int q = 0; q < 16; ++q) { oa[q][0] *= a4[q >> 2][q & 3]; oa[q][1] *= a4[q >> 2][q & 3]; }
        }
        dummy += tv0 + tv1;
        if (T < 64) {
            const char* vtb = cVb + (size_t)T * tile_b;
#pragma unroll 8
            for (int kl = 0; kl < 32; ++kl) {
                const f32x2 v2 = *(const GAS f32x2*)((vtb + (size_t)kl * (NH * DH * 4u)) + voff);
                f32x4 p4[4];
#pragma unroll
                for (int j = 0; j < 4; ++j) p4[j] = *(const LAS f32x4*)(Pw + kl * 16 + 4 * j);
#pragma unroll
                for (int q = 0; q < 16; ++q) { const float p = p4[q >> 2][q & 3]; oa[q][0] += p * v2.x; oa[q][1] += p * v2.y; }
            }
        } else {
            const bf16* vp = ((bf16*)(F.ws + WS_VB)) + (size_t)(SEQ + b * DECT) * D + h * DH + 2 * lane;
#pragma unroll 4
            for (int kl = 0; kl < 16; ++kl) {
                const unsigned vw = *(const GAS unsigned*)(vp + (size_t)kl * D);
                const float vx = bf_lo(vw), vy = bf_hi(vw);
                f32x4 p4[4];
#pragma unroll
                for (int j = 0; j < 4; ++j) p4[j] = *(const LAS f32x4*)(Pw + kl * 16 + 4 * j);
#pragma unroll
                for (int q = 0; q < 16; ++q) { const float p = p4[q >> 2][q & 3]; oa[q][0] += p * vx; oa[q][1] += p * vy; }
            }
        }
        asm volatile("s_waitcnt lgkmcnt(0)" ::: "memory"); __builtin_amdgcn_wave_barrier();
    }
#undef SA_TOUCHK
    if (dummy == 123.456f) Aw[0] = dummy;
    {
        const float ltot = lsum + __shfl_xor(lsum, 32);
        LAS float* Mb = (LAS float*)(lds + SA_M); LAS float* Lb = (LAS float*)(lds + SA_L); LAS float* Ob = (LAS float*)(lds + SA_O);
        if (lane < 16) { Mb[w * 16 + lane] = m; Lb[w * 16 + lane] = ltot; }
#pragma unroll
        for (int q = 0; q < 16; ++q) *(LAS f32x2*)(Ob + (w * 16 + q) * 128 + 2 * lane) = (f32x2){oa[q][0], oa[q][1]};
        __syncthreads();
        { const int q0 = tid >> 7, d = tid & 127;
          const LAS float* Mq = Mb + q0; const LAS float* Lq = Lb + q0; const LAS float* Oq = Ob + q0 * 128 + d;
#pragma unroll
          for (int i = 0; i < 4; ++i) {
            float mx = Mq[4 * i];
#pragma unroll
            for (int ww = 1; ww < 8; ++ww) mx = fmaxf(mx, Mq[ww * 16 + 4 * i]);
            float L = 0.f, ov = 0.f;
#pragma unroll
            for (int ww = 0; ww < 8; ++ww) { const float sc = __builtin_amdgcn_exp2f(Mq[ww * 16 + 4 * i] - mx); L += Lq[ww * 16 + 4 * i] * sc; ov += Oq[(ww * 16 + 4 * i) * 128] * sc; }
            ((bf16*)(F.ws + WS_OB))[(size_t)(SEQ + b * DECT + q0 + 4 * i) * D + h * DH + d] = (bf16)f2bf(ov / L);
          } }
        __syncthreads();
    }
}

constexpr int NPHASE = 21;
struct Args { const float* in[16]; float* out; unsigned char* ws; int ph_lo, ph_hi; };
__global__ void __launch_bounds__(NWAVES * 64, 2) trunk_fwd(Args args) {
    extern __shared__ __attribute__((aligned(16))) unsigned char lds[];
    Frame F;
    F.lds = (LAS unsigned char*)lds;
    const int wave_s = __builtin_amdgcn_readfirstlane((int)threadIdx.x >> 6);
#define REFRESH() do { unsigned _z = 0u; asm volatile("" : "+s"(_z)); const int _l = (int)__builtin_amdgcn_mbcnt_hi(~0u, __builtin_amdgcn_mbcnt_lo(~0u, _z)); F.lane = _l; F.wave = wave_s; F.tid = wave_s * 64 + _l; } while (0)
    REFRESH();
    F.G = gridDim.x; { const int bx = blockIdx.x; F.vcu = (F.G % 8 == 0) ? (bx % 8) * (F.G / 8) + bx / 8 : bx; }
    unsigned char* ws = args.ws;
    F.xP = args.in[0]; F.xS = args.in[1]; F.spool = args.in[2]; F.cK = args.in[3]; F.cV = args.in[4]; F.cLF = args.in[5]; F.lng = args.in[6]; F.lnb = args.in[7];
    F.w1 = args.in[8]; F.w3 = args.in[9]; F.w2 = args.in[10]; F.poolw = args.in[11]; F.pools = args.in[12]; F.win = args.in[13]; F.bfg = args.in[14]; F.wo = args.in[15];
    F.out = args.out; F.ctl = (unsigned*)(ws + WS_CTL);
    F.ws = ws;
    for (int u = F.tid; u < (LDS_BYTES - LDSCTL_OFF) / 4; u += NWAVES * 64) ((LAS unsigned*)(F.lds + LDSCTL_OFF))[u] = 0u;
    __syncthreads();
    volatile LAS unsigned* MISC = (volatile LAS unsigned*)(F.lds + MISC_OFF);
    XcdBarrier bar; bar.bar = (unsigned*)(ws + WS_CTL) + CW_BAR; bar.x = 0; bar.st = nullptr;
    if (!MK_SPLIT) bar = xcd_barrier_post((unsigned*)(ws + WS_CTL) + CW_BAR, MISC + 8, F.tid);
    const int lo = args.ph_lo, hi = args.ph_hi;
#ifdef ONLY_PHASE
#define IN(k) ((k) == ONLY_PHASE && lo <= (k) && (k) < hi)
#else
#define IN(k) (lo <= (k) && (k) < hi)
#endif
#ifdef PROBE_MASK_A
#define STAMP(k) do { if (blockIdx.x == 0) { if (F.tid == 0) { F.ctl[16384 + (k)] = (unsigned)__builtin_amdgcn_s_memrealtime(); asm volatile("s_waitcnt vmcnt(0)" ::: "memory"); } __syncthreads(); } } while (0)
#else
#define STAMP(k) do { } while (0)
#endif
#define SEAM(k) do { if (IN(k) && IN((k) + 1)) xcd_barrier(bar, F.tid); REFRESH(); STAMP((k) + 1); } while (0)
#define UP_PHASE(k, f) if (IN(k)) { pg8::Gemm g{((bf16*)(F.ws + WS_XBF)), ((bf16*)(F.ws + WS_W13)) + (size_t)(f) * 2 * FF * D, D, D, D, 128, 128}; pg8::StaticOrder S; S.init(M, 2 * FF, F.G, (int)blockIdx.x, D); S.dynL = 16 * F.G; S.dynw = F.ctl + CW_DY + 64 * (k); S.dynl = (LAS unsigned*)(F.lds + MISC_OFF + 64); \
        pg8::EpiSwiglu E{((bf16*)(F.ws + WS_HB))}; pg8::gemm_phase<pg8::EpiSwiglu, pg8::StaticOrder>(F.lds + RING_OFF, g, S, E, F.tid); convert_elastic(F, (f) + 1, false, F.ctl + CW_CD + 64 * (f)); } SEAM(k)
#define DOWN_PHASE(k, f, sp, ss, lni) if (IN(k)) { pg8::Gemm g{((bf16*)(F.ws + WS_HB)), ((bf16*)(F.ws + WS_W2T)) + (size_t)(f) * D * FFP, 64, 64, FF, (size_t)M * 128, (size_t)D * 128}; pg8::StaticOrder S; S.init(M, D, F.G, (int)blockIdx.x, FF, 0, 0, 8, 4); \
        pg8::EpiResid E{((float*)(F.ws + WS_S)), (sp), (ss), 0.5f, nullptr, ((float*)(F.ws + WS_ZS)), ((float*)(F.ws + WS_SLAB)), (lni) >= 0 ? ((float*)(F.ws + WS_ST)) : nullptr, F.lng + ((lni) >= 0 ? (lni) : 0) * D, F.lnb + ((lni) >= 0 ? (lni) : 0) * D, (lni) >= 0 ? nullptr : ((const bf16*)(F.ws + WS_XBF))}; pg8::gemm_phase<pg8::EpiResid, pg8::StaticOrder>(F.lds + RING_OFF, g, S, E, F.tid); if ((f) != 2) convert_elastic(F, (f) + 1, true, nullptr); } SEAM(k)

    STAMP(0);
    if (IN(0)) { p0_prologue(F); } SEAM(0);
    UP_PHASE(1, 0);
    DOWN_PHASE(2, 0, F.xP, F.xS, -1);
    if (IN(3)) { ln_pass<false, true, false, false, 8>(F, F.lng + 0 * D, F.lnb + 0 * D); } SEAM(3);
    if (IN(4)) { pool_pass(F); } SEAM(4);
    if (IN(5)) { pg8::Gemm g{((bf16*)(F.ws + WS_DB)), ((bf16*)(F.ws + WS_POOLT)), D, 512, 512, 128, 128}; pg8::StaticOrder S; S.init(M, D, F.G, (int)blockIdx.x, 512, 2, 512 * 2, 2);
        pg8::EpiResid E{((float*)(F.ws + WS_S)), ((float*)(F.ws + WS_S)), ((float*)(F.ws + WS_S)) + (size_t)SEQ * D, 1.0f, F.pools, ((float*)(F.ws + WS_ZS)), ((float*)(F.ws + WS_SLAB)), ((float*)(F.ws + WS_ST)), F.lng + 0 * D, F.lnb + 0 * D}; pg8::gemm_phase<pg8::EpiResid, pg8::StaticOrder>(F.lds + RING_OFF, g, S, E, F.tid); } SEAM(5);
    if (IN(6)) { ln_pass<true, false, false, false, 2>(F, F.lng + 1 * D, F.lnb + 1 * D); } SEAM(6);
    UP_PHASE(7, 1);
    DOWN_PHASE(8, 1, ((float*)(F.ws + WS_S)), ((float*)(F.ws + WS_S)) + (size_t)SEQ * D, 1);
    if (IN(9)) { ln_pass<true, false, false, false, 8>(F, F.lng + 2 * D, F.lnb + 2 * D); } SEAM(9);
    UP_PHASE(10, 2);
    DOWN_PHASE(11, 2, ((float*)(F.ws + WS_S)), ((float*)(F.ws + WS_S)) + (size_t)SEQ * D, 2);
    if (IN(12)) { ln_pass<true, false, true, false, 8>(F, F.lng + 3 * D, F.lnb + 3 * D); } SEAM(12);
    if (IN(13)) { pg8::Gemm g{((bf16*)(F.ws + WS_XBF)), ((bf16*)(F.ws + WS_WIN)), D, D, D, 128, 128}; pg8::StaticOrder S; S.init(M, 3 * D, F.G, (int)blockIdx.x, D);
        if (!((int)blockIdx.x >= 48 && (int)blockIdx.x < 48 + NH)) { S.dynw = F.ctl + CW_DY + 64 * 13; S.dynl = (LAS unsigned*)(F.lds + MISC_OFF + 64); } S.dynL = 6 * F.G;
        pg8::EpiQKV E{((bf16*)(F.ws + WS_QB)), (size_t)(WS_KB - WS_QB) / 2, F.out + O_KP, F.out + O_KS, ((bf16*)(F.ws + WS_VT)), F.ctl + CW_KMAX}; pg8::gemm_phase<pg8::EpiQKV, pg8::StaticOrder>(F.lds + RING_OFF, g, S, E, F.tid);
        if ((int)blockIdx.x >= 48 && (int)blockIdx.x < 48 + NH) cl_scan(F, (int)blockIdx.x - 48);
        convert_elastic(F, 3, true, nullptr);
    } SEAM(13);
    REFRESH();
    if (IN(15)) {
        {
            LAS unsigned* tick = (LAS unsigned*)(F.lds + RING_OFF + 126976);
#if !defined(ATT_ONLY) || ATT_ONLY == 2
            for (;;) {
                if (F.tid == 0) *tick = __hip_atomic_fetch_add(F.ctl + CW_Q2, 1u, __ATOMIC_RELAXED, __HIP_MEMORY_SCOPE_AGENT);
                __syncthreads();
                const int u = (int)*tick;
                __syncthreads();
                if (u >= DECB * NH) break;
                attn_sample_unit(F, u >> 4, u & 15);
            }
#endif
            STAMP(21);
            __syncthreads();
        {
            LAS float* kml = (LAS float*)(F.lds + RING_OFF + AT_C + 1024);
            const int hd = F.tid >> 5, l5 = F.tid & 31; const unsigned* kqh = F.ctl + CW_KMAX + (size_t)hd * 4 * 128;
            float bm = 0.f;
#pragma unroll
            for (int p4 = 0; p4 < 4; ++p4) { float bsum = 0.f;
#pragma unroll
                for (int qq = 0; qq < 4; ++qq) bsum += __uint_as_float(__hip_atomic_load(kqh + qq * 128 + l5 + 32 * p4, __ATOMIC_RELAXED, __HIP_MEMORY_SCOPE_AGENT));
                bm = fmaxf(bm, bsum); }
#pragma unroll
            for (int o = 1; o < 32; o <<= 1) bm = fmaxf(bm, __shfl_xor(bm, o));
            if (l5 == 0) kml[hd] = bm;
            __syncthreads();
        }
#if !defined(ATT_ONLY) || ATT_ONLY == 1
            for (;;) {
                if (F.tid == 0) *tick = __hip_atomic_fetch_add(F.ctl + CW_Q1, 1u, __ATOMIC_RELAXED, __HIP_MEMORY_SCOPE_AGENT);
                __syncthreads();
                const int u = (int)*tick;
                __syncthreads();
                if (u >= NH * 64) break;
                attn_prompt_unit(F, u & 15, 63 - (u >> 4));
            }
#endif
        }
    } SEAM(15);
    if (IN(16)) { pg8::Gemm g{((bf16*)(F.ws + WS_OB)), ((bf16*)(F.ws + WS_WO)), D, D, D, 128, 128}; pg8::StaticOrder S; S.init(M, D, F.G, (int)blockIdx.x, D, 0, 0, 4);
        pg8::EpiResid E{((float*)(F.ws + WS_S)), ((float*)(F.ws + WS_S)), ((float*)(F.ws + WS_S)) + (size_t)SEQ * D, 1.0f, nullptr, ((float*)(F.ws + WS_ZS)), ((float*)(F.ws + WS_SLAB)), ((float*)(F.ws + WS_ST)), F.lng + 3 * D, F.lnb + 3 * D}; pg8::gemm_phase<pg8::EpiResid, pg8::StaticOrder>(F.lds + RING_OFF, g, S, E, F.tid); } SEAM(16);
    if (IN(17)) { ln_pass<true, false, false, false, 4>(F, F.lng + 4 * D, F.lnb + 4 * D); } SEAM(17);
    UP_PHASE(18, 3);
    DOWN_PHASE(19, 3, ((float*)(F.ws + WS_S)), ((float*)(F.ws + WS_S)) + (size_t)SEQ * D, 4);
    if (IN(20)) { ln_pass<false, false, false, true, 8>(F, F.lng + 5 * D, F.lnb + 5 * D); }
#undef IN
#undef SEAM
#undef UP_PHASE
#undef DOWN_PHASE
}

extern "C" void kernel_launch(void* const* d_in, const int* in_sizes, int n_in, void* d_out, int out_size, void* d_ws, size_t ws_size, hipStream_t stream) {
    static int grid = 0;
    if (grid == 0) {
        if (n_in != 16 || (size_t)out_size != O_END || ws_size < WS_END) { fprintf(stderr, "kernel_launch: unexpected shapes (n_in %d, out %d, ws %zu)\n", n_in, out_size, ws_size); grid = -1; return; }
        int dev = 0, cus = 0, per_cu = 0;
        if (hipGetDevice(&dev) != hipSuccess || hipDeviceGetAttribute(&cus, hipDeviceAttributeMultiprocessorCount, dev) != hipSuccess) { grid = -1; return; }
        if (hipFuncSetAttribute((const void*)trunk_fwd, hipFuncAttributeMaxDynamicSharedMemorySize, LDS_BYTES) != hipSuccess) { fprintf(stderr, "kernel_launch: hipFuncSetAttribute failed\n"); grid = -1; return; }
        if (hipOccupancyMaxActiveBlocksPerMultiprocessor(&per_cu, (const void*)trunk_fwd, NWAVES * 64, LDS_BYTES) != hipSuccess || per_cu < 1)
            fprintf(stderr, "kernel_launch: occupancy query reports %d workgroups per CU\n", per_cu);
        (void)hipGetLastError();
        grid = cus;
    }
    if (grid < 0) return;
    (void)hipMemsetAsync((char*)d_ws + WS_CTL, 0, CTL_ZERO_BYTES, stream);
    Args a{};
    for (int i = 0; i < 16; ++i) a.in[i] = (const float*)d_in[i];
    a.out = (float*)d_out; a.ws = (unsigned char*)d_ws;
#if MK_SPLIT
    for (int k = 0; k < NPHASE; ++k) { a.ph_lo = k; a.ph_hi = k + 1; hipLaunchKernelGGL(trunk_fwd, dim3(grid), dim3(NWAVES * 64), LDS_BYTES, stream, a); }
#else
    a.ph_lo = 0; a.ph_hi = NPHASE; hipLaunchKernelGGL(trunk_fwd, dim3(grid), dim3(NWAVES * 64), LDS_BYTES, stream, a);
#endif
}
```
